# Optimizing an MI355X kernel written in HIP

```python
import math
import jax, jax.numpy as jnp
from jax import lax
import numpy as np

D_MODEL = 2048
BATCH = 8
SEQ = 2048
DEPTH = 1
DEC_BATCH = 1
DEC_SEQ = 16384
PAST_LEN = 128

HEAD_DIM = 128
A_HEADS = 8
A_KV_HEADS = 2
A_GROUP = A_HEADS // A_KV_HEADS
WINDOW = 128
BLOCK = 128
N_BUCKETS = 32
MAX_DISTANCE = 128
B_HEADS = 8
KV_RANK = 512
QK_NOPE = 128
QK_ROPE = 64
V_DIM = 128
ROPE_THETA = 10000.0
D_FF = 4 * D_MODEL
EPS = 1e-6
NEG = -1e30

A_Q = A_HEADS * HEAD_DIM
A_KV = A_KV_HEADS * HEAD_DIM
B_QN = B_HEADS * QK_NOPE
B_QR = B_HEADS * QK_ROPE
D_IN = A_Q + 2 * A_KV + B_QN + B_QR + KV_RANK + QK_ROPE
D_MIX_OUT = A_HEADS * HEAD_DIM + B_HEADS * V_DIM

kernel_name = "hymba_swa_mla_adaln_encoder"


def rmsnorm(x, g):
    xf = x.astype(jnp.float32)
    y = xf * lax.rsqrt(jnp.mean(xf * xf, axis=-1, keepdims=True) + EPS)
    return (y * g.astype(jnp.float32)).astype(x.dtype)


def t5_bucket(rel):
    half = N_BUCKETS // 2
    max_exact = half // 2
    ret = jnp.where(rel > 0, half, 0)
    n = jnp.abs(rel)
    nf = jnp.maximum(n, 1).astype(jnp.float32)
    large = max_exact + (jnp.log(nf / max_exact) / math.log(MAX_DISTANCE / max_exact)
                         * (half - max_exact)).astype(jnp.int32)
    large = jnp.minimum(large, half - 1)
    return ret + jnp.where(n < max_exact, n, large)


def rope(x, pos):
    half = QK_ROPE // 2
    inv = ROPE_THETA ** (-jnp.arange(half, dtype=jnp.float32) / half)
    ang = pos.astype(jnp.float32)[:, None] * inv[None, :]
    cos = jnp.cos(ang)[:, None, :]
    sin = jnp.sin(ang)[:, None, :]
    xf = x.astype(jnp.float32)
    x1, x2 = xf[..., :half], xf[..., half:]
    return jnp.concatenate([x1 * cos - x2 * sin, x1 * sin + x2 * cos], axis=-1).astype(x.dtype)


def window_attention(q, k, v, sink, rel_bias):
    B, S = q.shape[0], q.shape[1]
    nb = S // BLOCK
    qb = q.reshape(B, nb, BLOCK, A_KV_HEADS, A_GROUP, HEAD_DIM)
    pad = ((0, 0), (BLOCK, BLOCK), (0, 0), (0, 0))
    kp = jnp.pad(k, pad).reshape(B, nb + 2, BLOCK, A_KV_HEADS, HEAD_DIM)
    vp = jnp.pad(v, pad).reshape(B, nb + 2, BLOCK, A_KV_HEADS, HEAD_DIM)
    kb = jnp.concatenate([kp[:, :-2], kp[:, 1:-1], kp[:, 2:]], axis=2)
    vb = jnp.concatenate([vp[:, :-2], vp[:, 1:-1], vp[:, 2:]], axis=2)
    s = jnp.einsum('bnqgrd,bnkgd->bngrqk', qb, kb,
                   preferred_element_type=jnp.float32) * (HEAD_DIM ** -0.5)
    q_off = jnp.arange(BLOCK)[:, None]
    k_off = jnp.arange(3 * BLOCK)[None, :] - BLOCK
    rel = k_off - q_off
    bias = rel_bias.astype(jnp.float32)[t5_bucket(rel)]
    bias = bias.transpose(2, 0, 1).reshape(A_KV_HEADS, A_GROUP, BLOCK, 3 * BLOCK)
    k_abs = jnp.arange(nb)[:, None] * BLOCK + k_off
    valid = (jnp.abs(rel) <= WINDOW)[None] & ((k_abs >= 0) & (k_abs < S))[:, None, :]
    s = jnp.where(valid[None, :, None, None], s + bias, NEG)
    sink_l = sink.astype(jnp.float32).reshape(A_KV_HEADS, A_GROUP)[None, None, :, :, None, None]
    m = jnp.maximum(jnp.max(s, axis=-1, keepdims=True), sink_l)
    p = jnp.exp(s - m)
    denom = jnp.sum(p, axis=-1, keepdims=True) + jnp.exp(sink_l - m)
    p = (p / denom).astype(v.dtype)
    o = jnp.einsum('bngrqk,bnkgd->bnqgrd', p, vb)
    return o.reshape(B, S, A_HEADS * HEAD_DIM)


def latent_attention(q_nope, q_rope, c_kv, k_rope, g_kv, w_kv_b):
    B, S = q_nope.shape[0], q_nope.shape[1]
    pos = jnp.arange(S)
    qr = rope(q_rope.reshape(B, S, B_HEADS, QK_ROPE), pos)
    kr = rope(k_rope[:, :, None, :], pos)[:, :, 0]
    kv = (rmsnorm(c_kv, g_kv) @ w_kv_b).reshape(B, S, B_HEADS, QK_NOPE + V_DIM)
    k_nope, v = kv[..., :QK_NOPE], kv[..., QK_NOPE:]
    qn = q_nope.reshape(B, S, B_HEADS, QK_NOPE)
    scale = (QK_NOPE + QK_ROPE) ** -0.5
    nb = S // BLOCK
    qn_b = qn.reshape(B, nb, BLOCK, B_HEADS, QK_NOPE).transpose(1, 0, 2, 3, 4)
    qr_b = qr.reshape(B, nb, BLOCK, B_HEADS, QK_ROPE).transpose(1, 0, 2, 3, 4)

    def attend(blk):
        qn_i, qr_i = blk
        s = (jnp.einsum('bqhd,bkhd->bhqk', qn_i, k_nope, preferred_element_type=jnp.float32)
             + jnp.einsum('bqhr,bkr->bhqk', qr_i, kr, preferred_element_type=jnp.float32)) * scale
        p = jax.nn.softmax(s, axis=-1).astype(v.dtype)
        return jnp.einsum('bhqk,bkhd->bqhd', p, v)

    o = lax.map(attend, (qn_b, qr_b))
    return o.transpose(1, 0, 2, 3, 4).reshape(B, S, B_HEADS * V_DIM)


def trunk(x, c, w_ada, b_ada, g_mix, w_in, sink, g_kv, w_kv_b, w_o,
          g_mlp, w_ff1, w_ff2, rel_bias, g_final):
    B, S, _ = x.shape
    splits = np.cumsum([A_Q, A_KV, A_KV, B_QN, B_QR, KV_RANK]).tolist()
    for l in range(DEPTH):
        mod = jax.nn.silu(c) @ w_ada[l] + b_ada[l]
        sh1, sc1, gt1, sh2, sc2, gt2 = jnp.split(mod[:, None, :], 6, axis=-1)
        h = rmsnorm(x, g_mix[l]) * (1 + sc1) + sh1
        proj = h @ w_in[l]
        qa, ka, va, qn, qr, ckv, kr = jnp.split(proj, splits, axis=-1)
        out_a = window_attention(qa.reshape(B, S, A_HEADS, HEAD_DIM),
                                 ka.reshape(B, S, A_KV_HEADS, HEAD_DIM),
                                 va.reshape(B, S, A_KV_HEADS, HEAD_DIM),
                                 sink[l], rel_bias)
        out_b = latent_attention(qn, qr, ckv, kr, g_kv[l], w_kv_b[l])
        x = x + gt1 * (jnp.concatenate([out_a, out_b], axis=-1) @ w_o[l])
        h = rmsnorm(x, g_mlp[l]) * (1 + sc2) + sh2
        f = jnp.square(jax.nn.relu(h @ w_ff1[l])) @ w_ff2[l]
        x = x + gt2 * f
    return rmsnorm(x, g_final)


def setup_inputs(seed: int = 0) -> dict:
    key = jax.random.key(seed)
    ks = jax.random.split(key, 20)
    f32 = jnp.float32

    def nrm(k, shape, scale):
        return jax.random.normal(k, shape, f32) * scale

    return {
        "x_prompt": nrm(ks[0], (BATCH, SEQ, D_MODEL), 1.0),
        "x_sample": nrm(ks[1], (DEC_BATCH, DEC_SEQ, D_MODEL), 1.0),
        "c_prompt": nrm(ks[2], (BATCH, D_MODEL), 1.0),
        "c_sample": nrm(ks[3], (DEC_BATCH, D_MODEL), 1.0),
        "w_ada": nrm(ks[4], (DEPTH, D_MODEL, 6 * D_MODEL), 0.5 * D_MODEL ** -0.5),
        "b_ada": nrm(ks[5], (DEPTH, 6 * D_MODEL), 0.02),
        "g_mix": 1.0 + nrm(ks[6], (DEPTH, D_MODEL), 0.02),
        "w_in": nrm(ks[7], (DEPTH, D_MODEL, D_IN), D_MODEL ** -0.5),
        "sink": nrm(ks[8], (DEPTH, A_HEADS), 0.5),
        "g_kv": 1.0 + nrm(ks[9], (DEPTH, KV_RANK), 0.02),
        "w_kv_b": nrm(ks[10], (DEPTH, KV_RANK, B_HEADS * (QK_NOPE + V_DIM)), KV_RANK ** -0.5),
        "w_o": nrm(ks[11], (DEPTH, D_MIX_OUT, D_MODEL), D_MIX_OUT ** -0.5),
        "g_mlp": 1.0 + nrm(ks[12], (DEPTH, D_MODEL), 0.02),
        "w_ff1": nrm(ks[13], (DEPTH, D_MODEL, D_FF), D_MODEL ** -0.5),
        "w_ff2": nrm(ks[14], (DEPTH, D_FF, D_MODEL), D_FF ** -0.5),
        "rel_bias": nrm(ks[15], (N_BUCKETS, A_HEADS), 0.5),
        "g_final": 1.0 + nrm(ks[16], (D_MODEL,), 0.02),
    }


def reference(x_prompt, x_sample, c_prompt, c_sample, w_ada, b_ada, g_mix, w_in, sink,
              g_kv, w_kv_b, w_o, g_mlp, w_ff1, w_ff2, rel_bias, g_final):
    y_prompt = trunk(x_prompt, c_prompt, w_ada, b_ada, g_mix, w_in, sink, g_kv, w_kv_b, w_o,
                     g_mlp, w_ff1, w_ff2, rel_bias, g_final)
    y_sample = trunk(x_sample, c_sample, w_ada, b_ada, g_mix, w_in, sink, g_kv, w_kv_b, w_o,
                     g_mlp, w_ff1, w_ff2, rel_bias, g_final)
    return (y_prompt, y_sample)
```

```cpp
#include <hip/hip_runtime.h>
#include <hip/hip_cooperative_groups.h>
#include <cstdio>
#include <cstdint>
namespace cg = cooperative_groups;

#define LAS __attribute__((address_space(3)))
typedef unsigned short bf16_t;
typedef short bf16x8 __attribute__((ext_vector_type(8)));
typedef short s16x4 __attribute__((ext_vector_type(4)));
typedef float f32x4 __attribute__((ext_vector_type(4)));
typedef float f32x2 __attribute__((ext_vector_type(2)));
typedef float f32x16 __attribute__((ext_vector_type(16)));
typedef unsigned u32x4 __attribute__((ext_vector_type(4)));
typedef unsigned u32x2 __attribute__((ext_vector_type(2)));

constexpr int DM = 2048, NTOK = 32768, NPROMPT = 16384, SEQP = 2048, SEQS = 16384, DFF = 8192;
constexpr int LDP = 3840;
constexpr int C_QA = 0, C_QN = 1024, C_KA = 2048, C_VA = 2304, C_QR = 2560, C_CKV = 3072, C_KR = 3584;
constexpr int MODW = 6 * DM;
constexpr int FCH = 8192;
constexpr float EPS = 1e-6f;
constexpr float LOG2E = 1.4426950408889634f;

constexpr size_t WS_WIN = 0;
constexpr size_t WS_WKVB = WS_WIN + (size_t)LDP * DM * 2;
constexpr size_t WS_WO = WS_WKVB + (size_t)2048 * 512 * 2;
constexpr size_t WS_WFF1 = WS_WO + (size_t)DM * DM * 2;
constexpr size_t WS_WFF2 = WS_WFF1 + (size_t)DFF * DM * 2;
constexpr size_t WS_MOD = WS_WFF2 + (size_t)DM * DFF * 2;
constexpr size_t WS_PROJ = WS_MOD + (size_t)9 * MODW * 4 + 1024;
constexpr size_t WS_R2 = WS_PROJ + (size_t)NTOK * LDP * 2;
constexpr size_t WS_BAR = WS_R2 + (size_t)NTOK * DM * 2;
constexpr size_t WS_SS = WS_BAR + 16384;
constexpr size_t WS_SS2 = WS_SS + (size_t)NTOK * 8 * 4;
constexpr size_t WS_B2 = WS_SS2 + (size_t)NTOK * 4;
constexpr size_t WS_END = WS_B2 + (size_t)9 * DFF * 4;
constexpr int LDS_XB = 139264;
constexpr int LDS_BYTES = 139264 + 256;
constexpr int NPHASE = 17;

struct Params {
    const float* x_prompt; const float* x_sample; const float* c_prompt; const float* c_sample;
    const float* w_ada; const float* b_ada; const float* g_mix; const float* w_in; const float* sink;
    const float* g_kv; const float* w_kv_b; const float* w_o; const float* g_mlp; const float* w_ff1; const float* w_ff2;
    const float* rel_bias; const float* g_final;
    float* out; unsigned char* ws;
    int ph_lo, ph_hi, coop, pad;
};

__device__ __forceinline__ unsigned cvt_pk_bf16(float lo, float hi) { unsigned r; asm volatile("v_cvt_pk_bf16_f32 %0, %1, %2" : "=v"(r) : "v"(lo), "v"(hi)); return r; }
typedef __bf16 bf16x2_t __attribute__((ext_vector_type(2)));
__device__ __forceinline__ unsigned cvt_pk_nv(float lo, float hi) { f32x2 v = {lo, hi}; bf16x2_t c = __builtin_convertvector(v, bf16x2_t); return *reinterpret_cast<unsigned*>(&c); }
__device__ __forceinline__ float bf2f(bf16_t b) { return __uint_as_float(((unsigned)b) << 16); }
__device__ __forceinline__ bf16_t f2bf(float f) { return (bf16_t)(cvt_pk_bf16(f, 0.f) & 0xffffu); }
__device__ __forceinline__ float wave_sum(float v) {
#pragma unroll
    for (int o = 32; o >= 1; o >>= 1) v += __shfl_xor(v, o);
    return v;
}

#define XB_TMO      128
#define XB_XCNT(j)  (256  + 64 * (j))
#define XB_XSUB(j)  (1280 + 64 * (j))
#define XB_XGEN(j)  (2304 + 64 * (j))
#define XB_TOP      3328
#define XB_TOPGEN   3392
#define XCD_BAR_WORDS 3456
#define XB_SPIN_CAP (1u << 20)
__device__ __forceinline__ unsigned xb_ld(unsigned* p)              { return __hip_atomic_load(p, __ATOMIC_RELAXED, __HIP_MEMORY_SCOPE_AGENT); }
__device__ __forceinline__ unsigned xb_add(unsigned* p, unsigned v) { return __hip_atomic_fetch_add(p, v, __ATOMIC_RELAXED, __HIP_MEMORY_SCOPE_AGENT); }
__device__ __forceinline__ unsigned xb_xcc_id() { return (unsigned)__builtin_amdgcn_s_getreg((3 << 11) | 20) & 0xFu; }
#define XB_SPIN(cond, bar) do { unsigned _sp = 0; while (cond) { __builtin_amdgcn_s_sleep(1); \
    if ((++_sp & 255u) == 0u) { if (xb_ld(&(bar)[XB_TMO])) break; if (_sp > XB_SPIN_CAP) { atomicAdd(&(bar)[XB_TMO], 1u); break; } } } } while (0)
struct XcdBarrier { unsigned* bar; unsigned x; volatile LAS unsigned* st; };
__device__ __forceinline__ XcdBarrier xcd_barrier_post(unsigned* bar, volatile LAS unsigned* st) {
    XcdBarrier b; b.bar = bar; b.x = xb_xcc_id(); b.st = st;
    if (threadIdx.x == 0) st[2] = xb_add(&bar[XB_XCNT(b.x)], 1u);
    return b;
}
__device__ __forceinline__ void xcd_barrier_complete(unsigned* bar, unsigned x, unsigned& nloc, unsigned& nx) {
    const unsigned G = gridDim.x * gridDim.y * gridDim.z;
    unsigned sum, cnt, mine, sp = 0u;
    for (;;) {
        sum = 0u; cnt = 0u; mine = 0u;
#pragma unroll
        for (unsigned j = 0; j < 16; ++j) { const unsigned c = xb_ld(&bar[XB_XCNT(j)]); sum += c; cnt += (c > 0u) ? 1u : 0u; mine = (j == x) ? c : mine; }
        if (sum == G) break;
        __builtin_amdgcn_s_sleep(1);
        if ((++sp & 255u) == 0u) { if (xb_ld(&bar[XB_TMO])) break; if (sp > XB_SPIN_CAP) { atomicAdd(&bar[XB_TMO], 1u); break; } }
    }
    nloc = mine > 0u ? mine : 1u; nx = cnt > 0u ? cnt : 1u;
}
__device__ __forceinline__ void xcd_barrier(const XcdBarrier& b) {
    asm volatile("s_waitcnt vmcnt(0)" ::: "memory");
    __syncthreads();
    if (threadIdx.x == 0) {
        unsigned* bar = b.bar;
        __builtin_amdgcn_s_waitcnt(0);
        unsigned nloc = b.st[0], nx = b.st[1];
        if (nloc == 0u) { xcd_barrier_complete(bar, b.x, nloc, nx); b.st[0] = nloc; b.st[1] = nx; }
        const unsigned old = xb_add(&bar[XB_XSUB(b.x)], 1u);
        const unsigned gen = old / nloc;
        if (old + 1u == (gen + 1u) * nloc) {
            __builtin_amdgcn_fence(__ATOMIC_RELEASE, "agent");
            asm volatile("s_waitcnt vmcnt(0)" ::: "memory");
            const unsigned og = xb_add(&bar[XB_TOP], 1u);
            const unsigned tg = og / nx;
            if (og + 1u == (tg + 1u) * nx) xb_add(&bar[XB_TOPGEN], 1u);
            else XB_SPIN(xb_ld(&bar[XB_TOPGEN]) == tg, bar);
            __builtin_amdgcn_fence(__ATOMIC_ACQUIRE, "agent");
            xb_add(&bar[XB_XGEN(b.x)], 1u);
            asm volatile("s_waitcnt vmcnt(0)" ::: "memory");
        } else {
            XB_SPIN(xb_ld(&bar[XB_XGEN(b.x)]) == gen, bar);
            __builtin_amdgcn_fence(__ATOMIC_ACQUIRE, "agent");
            asm volatile("s_waitcnt vmcnt(0)" ::: "memory");
        }
    }
    __syncthreads();
}


namespace pg8 {
constexpr int BM = 256, BK = 64, HALF = 128, HTB = HALF * BK * 2, STAGE_BYTES = 8 * HTB, NXCD = 8, WGM = 8;
__host__ __device__ __forceinline__ int lds_byte(int r, int c) { const int st = (r >> 4) * 2 + (c >> 5), rr = r & 15, cc = c & 31, ob = rr * 64 + cc * 2; return st * 1024 + (ob ^ (((ob >> 9) & 1) << 5)); }
__host__ __device__ __forceinline__ void stage_rc(int b, int& R, int& C) { const int st = b / 1024, sb = b % 1024, swz = sb ^ (((sb >> 9) & 1) << 5); R = (st >> 1) * 16 + swz / 64; C = (st & 1) * 32 + (swz % 64) / 2; }
__host__ __device__ __forceinline__ int perm32(int rho) { const int n = rho >> 4, i = rho & 15; return 8 * (i >> 2) + 4 * n + (i & 3); }

struct Unit { int pm, pn; };
struct Gemm { const bf16_t* A; int lda; const bf16_t* Bt; int M, N, K; };

struct StaticOrder {
    int nM, nN, nwg, G, c;
    __device__ void init(int M, int N, int G_, int c_) { nM = M / BM; nN = N / BM; nwg = nM * nN; G = G_; c = c_; }
    __device__ bool next(int i, Unit& u) const {
        const long L = (long)i * G + c; if (L >= nwg) return false;
        int wgid = (int)L; { const int q = nwg / NXCD, r = nwg % NXCD, xcd = wgid % NXCD, off = wgid / NXCD; wgid = (xcd < r ? xcd * (q + 1) : r * (q + 1) + (xcd - r) * q) + off; }
        const int nig = WGM * nN, gid = wgid / nig, fm = gid * WGM, gsz = (nM - fm) < WGM ? (nM - fm) : WGM;
        u.pm = fm + ((wgid % nig) % gsz); u.pn = (wgid % nig) / gsz; return true;
    }
};

template <int ACT  > struct EpiBf16 {
    static constexpr bool PERM = true, AFTER_DRAIN = false;
    bf16_t* O; int ldc;
    __device__ __forceinline__ void operator()(const f32x4 (&acc)[2][2][4][2], const Unit& u, int wr, int wc, int fr, int fq) const {
        const int row0 = u.pm * BM + wr * 64 + fr; const int col0 = u.pn * BM + wc * 32 + 8 * fq;
#pragma unroll
        for (int ai = 0; ai < 2; ++ai)
#pragma unroll
            for (int m = 0; m < 4; ++m) { bf16_t* rowp = O + (size_t)(row0 + ai * HALF + m * 16) * ldc + col0;
#pragma unroll
                for (int bj = 0; bj < 2; ++bj) { f32x4 v0 = acc[ai][bj][m][0], v1 = acc[ai][bj][m][1];
                    if (ACT == 3) {
#pragma unroll
                        for (int j = 0; j < 4; ++j) { const float a = fmaxf(v0[j], 0.f), b = fmaxf(v1[j], 0.f); v0[j] = a * a; v1[j] = b * b; } }
                    u32x4 w; w.x = cvt_pk_bf16(v0[0], v0[1]); w.y = cvt_pk_bf16(v0[2], v0[3]); w.z = cvt_pk_bf16(v1[0], v1[1]); w.w = cvt_pk_bf16(v1[2], v1[3]);
                    *(u32x4*)(rowp + bj * HALF) = w; } }
    }
};
struct EpiResGate {
    static constexpr bool PERM = false, AFTER_DRAIN = false;
    const float* xa; const float* xb; float* out; const float* gate; int row_off;
    __device__ __forceinline__ void operator()(const f32x4 (&acc)[2][2][4][2], const Unit& u, int wr, int wc, int fr, int fq) const {
        const int trow = row_off + u.pm * BM; const int batch = trow < NPROMPT ? (trow >> 11) : 8;
        const int row0 = trow + wr * 64 + fr, col0 = u.pn * BM + wc * 32 + 4 * fq;
        const float* gp = gate + (size_t)batch * MODW + col0;
        f32x4 gv[2][2];
#pragma unroll
        for (int bj = 0; bj < 2; ++bj)
#pragma unroll
            for (int n = 0; n < 2; ++n) gv[bj][n] = *(const f32x4*)(gp + bj * HALF + n * 16);
#pragma unroll
        for (int ai = 0; ai < 2; ++ai)
#pragma unroll
            for (int m = 0; m < 4; ++m) { const int row = row0 + ai * HALF + m * 16;
                const float* src = (row < NPROMPT ? xa + (size_t)row * DM : xb + (size_t)(row - NPROMPT) * DM) + col0; float* dst = out + (size_t)row * DM + col0;
#pragma unroll
                for (int bj = 0; bj < 2; ++bj)
#pragma unroll
                    for (int n = 0; n < 2; ++n) { const f32x4 b = *(const f32x4*)(src + bj * HALF + n * 16); *(f32x4*)(dst + bj * HALF + n * 16) = b + gv[bj][n] * acc[ai][bj][m][n]; } }
    }
};

struct EpiWo {
    static constexpr bool PERM = false, AFTER_DRAIN = false;
    const float* xa; const float* xb; float* out; const float* mod; const float* gmlp; bf16_t* U; float* ss2;
    __device__ __forceinline__ void operator()(const f32x4 (&acc)[2][2][4][2], const Unit& u, int wr, int wc, int fr, int fq) const {
        const int trow = u.pm * BM; const int batch = trow < NPROMPT ? (trow >> 11) : 8;
        const int row0 = trow + wr * 64 + fr, col0 = u.pn * BM + wc * 32 + 4 * fq;
        const float* mb = mod + (size_t)batch * MODW + col0;
        f32x4 gv[2][2], mv[2][2];
#pragma unroll
        for (int bj = 0; bj < 2; ++bj)
#pragma unroll
            for (int n = 0; n < 2; ++n) { gv[bj][n] = *(const f32x4*)(mb + 2 * DM + bj * HALF + n * 16);
                mv[bj][n] = *(const f32x4*)(gmlp + col0 + bj * HALF + n * 16) * (1.f + *(const f32x4*)(mb + 4 * DM + bj * HALF + n * 16)); }
        f32x4 xr[2][4];
#define WO_LOAD(buf, g) do { const int row_ = row0 + ((g) >> 2) * HALF + ((g) & 3) * 16; \
            const float* src_ = (row_ < NPROMPT ? xa + (size_t)row_ * DM : xb + (size_t)(row_ - NPROMPT) * DM) + col0; \
            _Pragma("unroll") for (int q_ = 0; q_ < 4; ++q_) xr[buf][q_] = *(const f32x4*)(src_ + (q_ >> 1) * HALF + (q_ & 1) * 16); } while (0)
        WO_LOAD(0, 0);
#pragma unroll
        for (int g = 0; g < 8; ++g) { const int ai = g >> 2, m = g & 3; const int row = row0 + ai * HALF + m * 16;
            if (g + 1 < 8) WO_LOAD((g + 1) & 1, g + 1);
            float* dst = out + (size_t)row * DM + col0; bf16_t* ud = U + (size_t)row * DM + col0; float sq = 0.f;
#pragma unroll
            for (int bj = 0; bj < 2; ++bj)
#pragma unroll
                for (int n = 0; n < 2; ++n) { const f32x4 v = xr[g & 1][bj * 2 + n] + gv[bj][n] * acc[ai][bj][m][n];
                    *(f32x4*)(dst + bj * HALF + n * 16) = v; sq += v[0] * v[0] + v[1] * v[1] + v[2] * v[2] + v[3] * v[3];
                    const f32x4 uu = v * mv[bj][n]; u32x2 w; w.x = cvt_pk_bf16(uu[0], uu[1]); w.y = cvt_pk_bf16(uu[2], uu[3]); *(u32x2*)(ud + bj * HALF + n * 16) = w; }
            sq += __shfl_xor(sq, 16); sq += __shfl_xor(sq, 32);
            if (fq == 0) (void)__hip_atomic_fetch_add(ss2 + row, sq, __ATOMIC_RELAXED, __HIP_MEMORY_SCOPE_AGENT); }
#undef WO_LOAD
    }
};
struct EpiFfn1 {
    static constexpr bool PERM = true, AFTER_DRAIN = false;
    bf16_t* O; const float* ss2; const float* bias2; int row_off;
    __device__ __forceinline__ void operator()(const f32x4 (&acc)[2][2][4][2], const Unit& u, int wr, int wc, int fr, int fq) const {
        const int trow = row_off + u.pm * BM; const int batch = trow < NPROMPT ? (trow >> 11) : 8;
        const int row0 = u.pm * BM + wr * 64 + fr; const int col0 = u.pn * BM + wc * 32 + 8 * fq;
        const float* bp = bias2 + (size_t)batch * DFF + col0;
        f32x4 bv[2][2];
#pragma unroll
        for (int bj = 0; bj < 2; ++bj)
#pragma unroll
            for (int n = 0; n < 2; ++n) bv[bj][n] = *(const f32x4*)(bp + bj * HALF + 4 * n);
        float ssv[2][4];
#pragma unroll
        for (int ai = 0; ai < 2; ++ai)
#pragma unroll
            for (int m = 0; m < 4; ++m) ssv[ai][m] = ss2[row_off + row0 + ai * HALF + m * 16];
#pragma unroll
        for (int ai = 0; ai < 2; ++ai)
#pragma unroll
            for (int m = 0; m < 4; ++m) asm volatile("" : "+v"(ssv[ai][m]));
#pragma unroll
        for (int ai = 0; ai < 2; ++ai)
#pragma unroll
            for (int m = 0; m < 4; ++m) { const int lrow = row0 + ai * HALF + m * 16; bf16_t* rowp = O + (size_t)lrow * DFF + col0;
                const float rs = rsqrtf(ssv[ai][m] * (1.f / DM) + EPS);
#pragma unroll
                for (int bj = 0; bj < 2; ++bj) { f32x4 v0 = acc[ai][bj][m][0] * rs + bv[bj][0], v1 = acc[ai][bj][m][1] * rs + bv[bj][1];
#pragma unroll
                    for (int j = 0; j < 4; ++j) { const float a = fmaxf(v0[j], 0.f), b = fmaxf(v1[j], 0.f); v0[j] = a * a; v1[j] = b * b; }
                    u32x4 w; w.x = cvt_pk_bf16(v0[0], v0[1]); w.y = cvt_pk_bf16(v0[2], v0[3]); w.z = cvt_pk_bf16(v1[0], v1[1]); w.w = cvt_pk_bf16(v1[2], v1[3]);
                    *(u32x4*)(rowp + bj * HALF) = w; } }
    }
};
struct EpiFinal {
    static constexpr bool PERM = false, AFTER_DRAIN = true;
    float* out; const float* gate; const float* gfinal; float* sspart; int row_off; XcdBarrier bar;
    __device__ __forceinline__ void fused(f32x4 (&acc)[2][2][4][2], const Unit& u, int wr, int wc, int fr, int fq, LAS unsigned char* lds) const {
        LAS float* P = (LAS float*)lds;
        LAS float* S = (LAS float*)(lds + 4096);
        const int trow = row_off + u.pm * BM; const int batch = trow < NPROMPT ? (trow >> 11) : 8;
        const int row0 = trow + wr * 64 + fr, col0 = u.pn * BM + wc * 32 + 4 * fq;
        {
            const float* gp = gate + (size_t)batch * MODW + col0;
            f32x4 gv[2][2];
#pragma unroll
            for (int bj = 0; bj < 2; ++bj)
#pragma unroll
                for (int n = 0; n < 2; ++n) gv[bj][n] = *(const f32x4*)(gp + bj * HALF + n * 16);
            f32x4 xr[3][4];
#define FN_LOAD(buf, g) do { const float* src_ = out + (size_t)(row0 + ((g) >> 2) * HALF + ((g) & 3) * 16) * DM + col0; \
                _Pragma("unroll") for (int q_ = 0; q_ < 4; ++q_) xr[buf][q_] = *(const f32x4*)(src_ + (q_ >> 1) * HALF + (q_ & 1) * 16); } while (0)
            FN_LOAD(0, 0); FN_LOAD(1, 1);
#pragma unroll
            for (int g = 0; g < 8; ++g) { const int ai = g >> 2, m = g & 3; float sq = 0.f;
                if (g + 2 < 8) FN_LOAD((g + 2) % 3, g + 2);
#pragma unroll
                for (int bj = 0; bj < 2; ++bj)
#pragma unroll
                    for (int n = 0; n < 2; ++n) { const f32x4 v = xr[g % 3][bj * 2 + n] + gv[bj][n] * acc[ai][bj][m][n]; acc[ai][bj][m][n] = v;
                        sq += v[0] * v[0] + v[1] * v[1] + v[2] * v[2] + v[3] * v[3]; }
                sq += __shfl_xor(sq, 16); sq += __shfl_xor(sq, 32);
                if (fq == 0) P[(ai * HALF + wr * 64 + m * 16 + fr) * 4 + wc] = sq; }
#undef FN_LOAD
        }
        __syncthreads();
        if (threadIdx.x < 256) { const int r = threadIdx.x; sspart[(size_t)(trow + r) * 8 + u.pn] = (P[r * 4] + P[r * 4 + 1]) + (P[r * 4 + 2] + P[r * 4 + 3]); }
        xcd_barrier(bar);
        if (threadIdx.x < 256) { const int r = threadIdx.x; const f32x4 a = *(const f32x4*)(sspart + (size_t)(trow + r) * 8), b = *(const f32x4*)(sspart + (size_t)(trow + r) * 8 + 4);
            const float tot = ((a[0] + a[1]) + (a[2] + a[3])) + ((b[0] + b[1]) + (b[2] + b[3])); S[r] = rsqrtf(tot * (1.f / DM) + EPS); }
        __syncthreads();
        f32x4 gf[2][2];
#pragma unroll
        for (int bj = 0; bj < 2; ++bj)
#pragma unroll
            for (int n = 0; n < 2; ++n) gf[bj][n] = *(const f32x4*)(gfinal + col0 + bj * HALF + n * 16);
#pragma unroll
        for (int ai = 0; ai < 2; ++ai)
#pragma unroll
            for (int m = 0; m < 4; ++m) { const int r = ai * HALF + wr * 64 + m * 16 + fr; const float rs = S[r]; float* dst = out + (size_t)(trow + r) * DM + col0;
#pragma unroll
                for (int bj = 0; bj < 2; ++bj)
#pragma unroll
                    for (int n = 0; n < 2; ++n) *(f32x4*)(dst + bj * HALF + n * 16) = acc[ai][bj][m][n] * rs * gf[bj][n]; }
    }
};

template <class Epi>
__device__ __forceinline__ void gemm_phase(LAS unsigned char* lds, const Gemm g, const StaticOrder& S, const Epi& E) {
    int tid_ = threadIdx.x; asm volatile("" : "+v"(tid_));
    const int tid = tid_, wid = __builtin_amdgcn_readfirstlane(tid >> 6), lane = tid & 63, wr = wid >> 2, wc = wid & 3, fr = lane & 15, fq = lane >> 4;
    const int K = g.K, nt = K / BK, lda = g.lda;
    unsigned voffA[2], voffB[2];
#pragma unroll
    for (int i = 0; i < 2; ++i) { int R, C; stage_rc(tid * 16 + i * 8192, R, C); const int Rb = Epi::PERM ? ((R & ~31) + perm32(R & 31)) : R;
        voffA[i] = (unsigned)(R * lda + C) * 2u; voffB[i] = (unsigned)(Rb * K + C) * 2u; }
    const size_t kstep = (size_t)(BK * 2);
    const size_t hstepA = (size_t)HALF * lda * 2, hstepB = (size_t)HALF * K * 2;
    const size_t tstepA = 2 * hstepA, tstepB = 2 * hstepB;
    const unsigned ldsw = (unsigned)wid * 1024u;
    const int aoff = lds_byte(wr * 64 + fr, fq * 8), boff = lds_byte(wc * 32 + fr, fq * 8);
#define PG8_SA(b, h) (((b) * 2 + (h)) * HTB)
#define PG8_SB(b, h) ((4 + (b) * 2 + (h)) * HTB)
#define PG8_STAGE(bufoff, gbase, voff) do { _Pragma("unroll") for (int _i = 0; _i < 2; ++_i) \
        __builtin_amdgcn_global_load_lds((const unsigned*)((const char*)(gbase) + (voff)[_i]), (LAS unsigned*)(lds + (bufoff) + ldsw + _i * 8192), 16, 0, 0); } while (0)
#define PG8_LDA(dst, b, h) do { _Pragma("unroll") for (int m = 0; m < 4; ++m) _Pragma("unroll") for (int k = 0; k < 2; ++k) dst[m][k] = *(const LAS bf16x8*)(lds + PG8_SA(b, h) + aoff + m * 2048 + k * 1024); } while (0)
#define PG8_LDB(dst, b, h) do { _Pragma("unroll") for (int n = 0; n < 2; ++n) _Pragma("unroll") for (int k = 0; k < 2; ++k) dst[n][k] = *(const LAS bf16x8*)(lds + PG8_SB(b, h) + boff + n * 2048 + k * 1024); } while (0)
#define PG8_MMA(ai, bj, At, Bt) do { __builtin_amdgcn_s_setprio(1); _Pragma("unroll") for (int m = 0; m < 4; ++m) _Pragma("unroll") for (int n = 0; n < 2; ++n) _Pragma("unroll") for (int k = 0; k < 2; ++k) \
        acc[ai][bj][m][n] = __builtin_amdgcn_mfma_f32_16x16x32_bf16(Bt[n][k], At[m][k], acc[ai][bj][m][n], 0, 0, 0); __builtin_amdgcn_s_setprio(0); } while (0)
#define PG8_WAIT_V(n) asm volatile("s_waitcnt vmcnt(" #n ")" ::: "memory")
#define PG8_WAIT_L(n) asm volatile("s_waitcnt lgkmcnt(" #n ")" ::: "memory")
#define PG8_BAR __builtin_amdgcn_s_barrier()
#define PG8_SCHED __builtin_amdgcn_sched_barrier(0)
    Unit cur, nxt; int ui = 0;
    if (!S.next(0, cur)) return;
    f32x4 acc[2][2][4][2];
#pragma unroll
    for (int a = 0; a < 2; ++a)
#pragma unroll
        for (int b = 0; b < 2; ++b)
#pragma unroll
            for (int m = 0; m < 4; ++m)
#pragma unroll
                for (int n = 0; n < 2; ++n) acc[a][b][m][n] = (f32x4){0.f, 0.f, 0.f, 0.f};
    bf16x8 At[4][2], B0[2][2], B1[2][2];
    const char* cA = (const char*)g.A + (size_t)cur.pm * tstepA; const char* cB = (const char*)g.Bt + (size_t)cur.pn * tstepB;
    PG8_STAGE(PG8_SB(0, 0), cB, voffB); PG8_STAGE(PG8_SA(0, 0), cA, voffA); PG8_STAGE(PG8_SB(0, 1), cB + hstepB, voffB); PG8_STAGE(PG8_SA(0, 1), cA + hstepA, voffA);
    if (wr == 1) PG8_BAR;
    PG8_WAIT_V(4); PG8_BAR;
    PG8_STAGE(PG8_SB(1, 0), cB + kstep, voffB); PG8_STAGE(PG8_SA(1, 0), cA + kstep, voffA); PG8_STAGE(PG8_SB(1, 1), cB + hstepB + kstep, voffB);
    PG8_WAIT_V(6); PG8_BAR;
    for (;;) {
        const bool has_next = S.next(ui + 1, nxt);
        const char* nA = has_next ? (const char*)g.A + (size_t)nxt.pm * tstepA : cA; const char* nB = has_next ? (const char*)g.Bt + (size_t)nxt.pn * tstepB : cB;
        for (int t = 0; t < nt; t += 2) {
            const bool last = (t == nt - 2);
            const char* a1 = cA + (size_t)(t + 1) * kstep;
            const char* a2 = last ? nA : cA + (size_t)(t + 2) * kstep; const char* b2 = last ? nB : cB + (size_t)(t + 2) * kstep;
            const char* a3 = a2 + kstep; const char* b3 = b2 + kstep;
            PG8_LDB(B0, 0, 0); PG8_SCHED; PG8_LDA(At, 0, 0); PG8_STAGE(PG8_SA(1, 1), a1 + hstepA, voffA);
            PG8_WAIT_L(8); PG8_BAR; PG8_WAIT_L(0); PG8_MMA(0, 0, At, B0); PG8_BAR; PG8_SCHED;
            PG8_LDB(B1, 0, 1); PG8_STAGE(PG8_SB(0, 0), b2, voffB);
            PG8_BAR; PG8_WAIT_L(0); PG8_MMA(0, 1, At, B1); PG8_BAR;
            PG8_LDA(At, 0, 1); PG8_STAGE(PG8_SA(0, 0), a2, voffA);
            PG8_BAR; PG8_WAIT_L(0); PG8_MMA(1, 0, At, B0); PG8_BAR; PG8_SCHED;
            PG8_STAGE(PG8_SB(0, 1), b2 + hstepB, voffB);
            PG8_WAIT_V(6); PG8_BAR; PG8_MMA(1, 1, At, B1); PG8_BAR;
            PG8_LDB(B0, 1, 0); PG8_SCHED; PG8_LDA(At, 1, 0); PG8_STAGE(PG8_SA(0, 1), a2 + hstepA, voffA);
            PG8_WAIT_L(8); PG8_BAR; PG8_WAIT_L(0); PG8_MMA(0, 0, At, B0); PG8_BAR; PG8_SCHED;
            PG8_LDB(B1, 1, 1); PG8_STAGE(PG8_SB(1, 0), b3, voffB);
            PG8_BAR; PG8_WAIT_L(0); PG8_MMA(0, 1, At, B1); PG8_BAR;
            PG8_LDA(At, 1, 1); PG8_STAGE(PG8_SA(1, 0), a3, voffA);
            PG8_BAR; PG8_WAIT_L(0); PG8_MMA(1, 0, At, B0); PG8_BAR; PG8_SCHED;
            PG8_STAGE(PG8_SB(1, 1), b3 + hstepB, voffB);
            PG8_WAIT_V(6); PG8_BAR; PG8_MMA(1, 1, At, B1); PG8_BAR;
        }
        if constexpr (!Epi::AFTER_DRAIN) E(acc, cur, wr, wc, fr, fq);
        if (!has_next) break;
#pragma unroll
        for (int a = 0; a < 2; ++a)
#pragma unroll
            for (int b = 0; b < 2; ++b)
#pragma unroll
                for (int m = 0; m < 4; ++m)
#pragma unroll
                    for (int n = 0; n < 2; ++n) acc[a][b][m][n] = (f32x4){0.f, 0.f, 0.f, 0.f};
        cur = nxt; cA = nA; cB = nB; ++ui;
    }
    PG8_WAIT_V(0);
    if (wr == 0) PG8_BAR;
    PG8_BAR;
    if constexpr (Epi::AFTER_DRAIN) E.fused(acc, cur, wr, wc, fr, fq, lds);
#undef PG8_SA
#undef PG8_SB
#undef PG8_STAGE
#undef PG8_LDA
#undef PG8_LDB
#undef PG8_MMA
#undef PG8_WAIT_V
#undef PG8_WAIT_L
#undef PG8_BAR
#undef PG8_SCHED
}
}


#ifndef ATT_WHOLE_TILE
#define ATT_WHOLE_TILE 1
#endif
#ifndef ATT_SDEPTH
#define ATT_SDEPTH 2
#endif
namespace att {
constexpr int SHM_V = 16384, SHM_K = 16384, SHM_KR = 8192;
constexpr int OFF_V = 0, OFF_K = 49152, OFF_KR = 81920, OFF_WS = 98304, OFF_BL = 100352, OFF_QR = 103424, ATT_LDS_END = 136192;
constexpr float SCALE_A = 0.088388347648318440f;
constexpr float SCALE_B = 0.072168783648703220f;
constexpr float THR = 8.f;
#define KSWZ(row, colB) ((row) * 256 + ((colB) ^ (((row) & 15) << 4)))
#define KRSWZ(row, colB) ((row) * 128 + ((colB) ^ ((((row) >> 1) & 7) << 4)))
#define SBAR() __builtin_amdgcn_sched_barrier(0)
__device__ __forceinline__ int crow(int r, int hi) { return (r & 3) + 8 * (r >> 2) + 4 * hi; }
__device__ __forceinline__ bf16x8 ld8(const bf16_t* p) { return *reinterpret_cast<const bf16x8*>(p); }

template <int MODE>
__device__ __forceinline__ void partialSM(f32x16& p0, f32x16& p1, float& m_reg, float& mn, float& alpha, const float* bl, int idx0) {
    if constexpr (MODE == 1) {
        constexpr float C = SCALE_B * LOG2E;
        float pmax = p0[0];
#pragma unroll
        for (int r = 1; r < 16; ++r) pmax = fmaxf(pmax, p0[r]);
#pragma unroll
        for (int r = 0; r < 16; ++r) pmax = fmaxf(pmax, p1[r]);
        { auto rr = __builtin_amdgcn_permlane32_swap(__float_as_uint(pmax), __float_as_uint(pmax), false, false);
          pmax = fmaxf(__uint_as_float(rr[0]), __uint_as_float(rr[1])); }
        if (__builtin_expect(__all(pmax - m_reg <= THR / SCALE_B), 1)) { mn = m_reg; alpha = 1.f; }
        else { mn = fmaxf(m_reg, pmax); alpha = __builtin_amdgcn_exp2f((m_reg - mn) * C); m_reg = mn; }
        const float mnC = -mn * C;
#pragma unroll
        for (int r = 0; r < 16; ++r) p0[r] = fmaf(p0[r], C, mnC);
#pragma unroll
        for (int r = 0; r < 16; ++r) p1[r] = fmaf(p1[r], C, mnC);
#pragma unroll
        for (int r = 0; r < 16; ++r) p0[r] = __builtin_amdgcn_exp2f(p0[r]);
    } else {
        constexpr float C = SCALE_A * LOG2E;
#pragma unroll
        for (int r4 = 0; r4 < 4; ++r4) {
#pragma unroll
            for (int e = 0; e < 4; ++e) { const int r = r4 * 4 + e, off = e + 8 * r4; p0[r] = fmaf(p0[r], C, bl[idx0 + off]); p1[r] = fmaf(p1[r], C, bl[idx0 + 32 + off]); }
            asm volatile("" ::: "memory");
        }
        float pmax = p0[0];
#pragma unroll
        for (int r = 1; r < 16; ++r) pmax = fmaxf(pmax, p0[r]);
#pragma unroll
        for (int r = 0; r < 16; ++r) pmax = fmaxf(pmax, p1[r]);
        { auto rr = __builtin_amdgcn_permlane32_swap(__float_as_uint(pmax), __float_as_uint(pmax), false, false);
          pmax = fmaxf(__uint_as_float(rr[0]), __uint_as_float(rr[1])); }
        if (__builtin_expect(__all(pmax - m_reg <= THR * LOG2E), 1)) { mn = m_reg; alpha = 1.f; }
        else { mn = fmaxf(m_reg, pmax); alpha = __builtin_amdgcn_exp2f(m_reg - mn); m_reg = mn; }
#pragma unroll
        for (int r = 0; r < 16; ++r) p0[r] = __builtin_amdgcn_exp2f(p0[r] - mn);
#pragma unroll
        for (int r = 0; r < 16; ++r) p1[r] = p1[r] - mn;
    }
}
__device__ __forceinline__ void finishSM(f32x16& p0, f32x16& p1, float alpha, float& l_reg, bf16x8& pa0, bf16x8& pa1, bf16x8& pa2, bf16x8& pa3) {
#pragma unroll
    for (int r = 0; r < 16; ++r) p1[r] = __builtin_amdgcn_exp2f(p1[r]);
    float ps = 0;
#pragma unroll
    for (int r = 0; r < 16; ++r) ps += p0[r];
#pragma unroll
    for (int r = 0; r < 16; ++r) ps += p1[r];
    { auto rr = __builtin_amdgcn_permlane32_swap(__float_as_uint(ps), __float_as_uint(ps), false, false);
      ps = __uint_as_float(rr[0]) + __uint_as_float(rr[1]); }
    l_reg = l_reg * alpha + ps;
#define PK4(P, BASE, OUT) do { unsigned a0 = cvt_pk_bf16(P[BASE + 0], P[BASE + 1]), a1 = cvt_pk_bf16(P[BASE + 2], P[BASE + 3]);   \
    unsigned b0 = cvt_pk_bf16(P[BASE + 4], P[BASE + 5]), b1 = cvt_pk_bf16(P[BASE + 6], P[BASE + 7]);                              \
    auto r0 = __builtin_amdgcn_permlane32_swap(a0, b0, false, false); auto r1 = __builtin_amdgcn_permlane32_swap(a1, b1, false, false); \
    u32x4 w = {r0[0], r1[0], r0[1], r1[1]}; OUT = *reinterpret_cast<bf16x8*>(&w); } while (0)
    PK4(p0, 0, pa0); PK4(p0, 8, pa1); PK4(p1, 0, pa2); PK4(p1, 8, pa3);
#undef PK4
}
template <int MODE>
__device__ __forceinline__ void qkt(f32x16& p0, f32x16& p1, const char* Ks, const char* Krs, const bf16x8* qr, const char* QRw, int qsw, int r32, int hi) {
    p0 = f32x16{}; p1 = f32x16{};
#pragma unroll
    for (int d0 = 0; d0 < 8; ++d0) { const int cb = (d0 * 16 + hi * 8) * 2;
        bf16x8 b0 = *reinterpret_cast<const bf16x8*>(Ks + KSWZ(r32, cb));
        bf16x8 b1 = *reinterpret_cast<const bf16x8*>(Ks + KSWZ(32 + r32, cb));
        p0 = __builtin_amdgcn_mfma_f32_32x32x16_bf16(b0, qr[d0], p0, 0, 0, 0);
        p1 = __builtin_amdgcn_mfma_f32_32x32x16_bf16(b1, qr[d0], p1, 0, 0, 0); }
    if constexpr (MODE == 1) {
#pragma unroll
        for (int d0 = 0; d0 < 4; ++d0) { const int cb = (d0 * 16 + hi * 8) * 2;
            bf16x8 b0 = *reinterpret_cast<const bf16x8*>(Krs + KRSWZ(r32, cb));
            bf16x8 b1 = *reinterpret_cast<const bf16x8*>(Krs + KRSWZ(32 + r32, cb));
            const bf16x8 qv = *reinterpret_cast<const bf16x8*>(QRw + (cb ^ qsw));
            p0 = __builtin_amdgcn_mfma_f32_32x32x16_bf16(b0, qv, p0, 0, 0, 0);
            p1 = __builtin_amdgcn_mfma_f32_32x32x16_bf16(b1, qv, p1, 0, 0, 0); }
    }
}
__device__ __forceinline__ int v_st(int k, int c) { const int kk = (k & ~0xC) | ((k & 4) << 1) | ((k & 8) >> 1); return ((kk >> 3) * 4 + (c >> 5)) * 512 + ((kk & 7) * 32 + (c & 31)) * 2; }
__device__ __forceinline__ int v_rd_base(int lane) { return ((lane & 3) << 3) | (((lane >> 2) & 3) << 6) | (((lane >> 4) & 1) << 5) | (((lane >> 5) & 1) << 8); }
constexpr int v_rd_off(int d0, int ks, int half) { return d0 * 512 + ks * 4096 + half * 2048; }
template <int OFF> __device__ __forceinline__ s16x4 tr_read(int vb) {
    s16x4 r; asm volatile("ds_read_b64_tr_b16 %0, %1 offset:%2" : "=&v"(r) : "v"(vb), "i"(OFF) : "memory"); return r;
}
template <int D0> __device__ __forceinline__ void pv_one(f32x16& od, int vb, bf16x8 pa0, bf16x8 pa1, bf16x8 pa2, bf16x8 pa3) {
    const s16x4 l0 = tr_read<v_rd_off(D0, 0, 0)>(vb), h0 = tr_read<v_rd_off(D0, 0, 1)>(vb), l1 = tr_read<v_rd_off(D0, 1, 0)>(vb), h1 = tr_read<v_rd_off(D0, 1, 1)>(vb);
    const s16x4 l2 = tr_read<v_rd_off(D0, 2, 0)>(vb), h2 = tr_read<v_rd_off(D0, 2, 1)>(vb), l3 = tr_read<v_rd_off(D0, 3, 0)>(vb), h3 = tr_read<v_rd_off(D0, 3, 1)>(vb);
    asm volatile("s_waitcnt lgkmcnt(0)" ::: "memory"); SBAR();
#define PK(L, H) (bf16x8){L[0], L[1], L[2], L[3], H[0], H[1], H[2], H[3]}
    od = __builtin_amdgcn_mfma_f32_32x32x16_bf16(pa0, PK(l0, h0), od, 0, 0, 0);
    od = __builtin_amdgcn_mfma_f32_32x32x16_bf16(pa1, PK(l1, h1), od, 0, 0, 0);
    od = __builtin_amdgcn_mfma_f32_32x32x16_bf16(pa2, PK(l2, h2), od, 0, 0, 0);
    od = __builtin_amdgcn_mfma_f32_32x32x16_bf16(pa3, PK(l3, h3), od, 0, 0, 0);
#undef PK
}
__device__ __forceinline__ void pv_d0(f32x16* o, int vb, bf16x8 pa0, bf16x8 pa1, bf16x8 pa2, bf16x8 pa3) {
    pv_one<0>(o[0], vb, pa0, pa1, pa2, pa3); pv_one<1>(o[1], vb, pa0, pa1, pa2, pa3); pv_one<2>(o[2], vb, pa0, pa1, pa2, pa3); pv_one<3>(o[3], vb, pa0, pa1, pa2, pa3);
}

template <int MODE>
__device__ __forceinline__ void qk_half(f32x16& p, const char* Ks, const char* Krs, int rowoff, const bf16x8* qr, const char* QRw, int qsw, int r32, int hi) {
    p = f32x16{};
#pragma unroll
    for (int d0 = 0; d0 < 8; ++d0) { const int cb = (d0 * 16 + hi * 8) * 2;
        const bf16x8 b = *reinterpret_cast<const bf16x8*>(Ks + KSWZ(rowoff + r32, cb));
        p = __builtin_amdgcn_mfma_f32_32x32x16_bf16(b, qr[d0], p, 0, 0, 0); }
    if constexpr (MODE == 1) {
#pragma unroll
        for (int d0 = 0; d0 < 4; ++d0) { const int cb = (d0 * 16 + hi * 8) * 2;
            const bf16x8 b = *reinterpret_cast<const bf16x8*>(Krs + KRSWZ(rowoff + r32, cb));
            p = __builtin_amdgcn_mfma_f32_32x32x16_bf16(b, qr[8 + d0], p, 0, 0, 0); }
#ifdef XTRA_MFMA
        bf16x8 qz = {0, 0, 0, 0, 0, 0, 0, 0}; asm volatile("" : "+v"(qz));
#pragma unroll
        for (int e = 0; e < XTRA_MFMA; ++e) p = __builtin_amdgcn_mfma_f32_32x32x16_bf16(qr[e & 7], qz, p, 0, 0, 0);
#endif
    }
}
template <int MODE>
__device__ __forceinline__ void half_max(f32x16& p, float& m_reg, float& mn, float& alpha, const float* bl, int idx) {
    if constexpr (MODE == 0) {
        constexpr float C = SCALE_A * LOG2E;
#pragma unroll
        for (int r4 = 0; r4 < 4; ++r4) {
#pragma unroll
            for (int e = 0; e < 4; ++e) { const int r = r4 * 4 + e, off = e + 8 * r4; p[r] = fmaf(p[r], C, bl[idx + off]); }
        }
    }
    float pmax = fmaxf(p[0], p[1]);
#pragma unroll
    for (int r = 2; r < 16; ++r) pmax = fmaxf(pmax, p[r]);
    { auto rr = __builtin_amdgcn_permlane32_swap(__float_as_uint(pmax), __float_as_uint(pmax), false, false);
      pmax = fmaxf(__uint_as_float(rr[0]), __uint_as_float(rr[1])); }
    if constexpr (MODE == 1) {
        constexpr float C = SCALE_B * LOG2E;
        if (__builtin_expect(__all(pmax - m_reg <= THR / SCALE_B), 1)) { mn = m_reg; alpha = 1.f; }
        else { mn = fmaxf(m_reg, pmax); alpha = __builtin_amdgcn_exp2f((m_reg - mn) * C); m_reg = mn; }
    } else {
        if (__builtin_expect(__all(pmax - m_reg <= THR * LOG2E), 1)) { mn = m_reg; alpha = 1.f; }
        else { mn = fmaxf(m_reg, pmax); alpha = __builtin_amdgcn_exp2f(m_reg - mn); m_reg = mn; }
    }
}
template <int MODE>
__device__ __forceinline__ void half_exp(f32x16& p, float mn, float alpha, float& l_reg, bf16x8& paA, bf16x8& paB) {
    if constexpr (MODE == 1) {
        constexpr float C = SCALE_B * LOG2E; const float mnC = -mn * C;
#pragma unroll
        for (int r = 0; r < 16; ++r) p[r] = __builtin_amdgcn_exp2f(fmaf(p[r], C, mnC));
    } else {
#pragma unroll
        for (int r = 0; r < 16; ++r) p[r] = __builtin_amdgcn_exp2f(p[r] - mn);
    }
    float ps = 0;
#pragma unroll
    for (int r = 0; r < 16; ++r) ps += p[r];
    { auto rr = __builtin_amdgcn_permlane32_swap(__float_as_uint(ps), __float_as_uint(ps), false, false);
      ps = __uint_as_float(rr[0]) + __uint_as_float(rr[1]); }
    l_reg = l_reg * alpha + ps;
#define PK4N(P, BASE, OUT) do { unsigned a0 = cvt_pk_nv(P[BASE + 0], P[BASE + 1]), a1 = cvt_pk_nv(P[BASE + 2], P[BASE + 3]);   \
    unsigned b0 = cvt_pk_nv(P[BASE + 4], P[BASE + 5]), b1 = cvt_pk_nv(P[BASE + 6], P[BASE + 7]);                              \
    auto r0 = __builtin_amdgcn_permlane32_swap(a0, b0, false, false); auto r1 = __builtin_amdgcn_permlane32_swap(a1, b1, false, false); \
    u32x4 w = {r0[0], r1[0], r0[1], r1[1]}; OUT = *reinterpret_cast<bf16x8*>(&w); } while (0)
    PK4N(p, 0, paA); PK4N(p, 8, paB);
#undef PK4N
}
template <int H>
__device__ __forceinline__ void pv_half(f32x16* o, unsigned vl, bf16x8 paA, bf16x8 paB) {
    typedef LAS s16x4* trp;
#define TRR(d0, ks, half) __builtin_amdgcn_ds_read_tr16_b64_v4i16((trp)(vl + (unsigned)v_rd_off(d0, ks, half)))
#define PKV(L, Hh) (bf16x8){L[0], L[1], L[2], L[3], Hh[0], Hh[1], Hh[2], Hh[3]}
#pragma unroll
    for (int d0 = 0; d0 < 4; ++d0) {
        const s16x4 lA = TRR(d0, 2 * H, 0), hA = TRR(d0, 2 * H, 1), lB = TRR(d0, 2 * H + 1, 0), hB = TRR(d0, 2 * H + 1, 1);
        o[d0] = __builtin_amdgcn_mfma_f32_32x32x16_bf16(paA, PKV(lA, hA), o[d0], 0, 0, 0);
        o[d0] = __builtin_amdgcn_mfma_f32_32x32x16_bf16(paB, PKV(lB, hB), o[d0], 0, 0, 0);
    }
#undef TRR
#undef PKV
}

template <int MODE>
__device__ __forceinline__ void attn_item(const bf16_t* __restrict__ Qb, const bf16_t* __restrict__ Qrb, const bf16_t* __restrict__ Kh, const bf16_t* __restrict__ Krh,
                                          const bf16_t* __restrict__ Vh, bf16_t* __restrict__ Ob, int NT, int relbase, float m_init, float l_init, char* lds) {
    constexpr int LDK = MODE ? 2048 : LDP;
    constexpr int SDEPTH = 1;
    int tid_ = threadIdx.x; asm volatile("" : "+v"(tid_));
    const int tid = tid_, wid = tid >> 6, lane = tid & 63, r32 = lane & 31, hi = lane >> 5;
    char* V_lds = lds + OFF_V; char* K_lds = lds + OFF_K; char* KR_lds = lds + OFF_KR;
    float* ws = (float*)(lds + OFF_WS) + wid * 64; float* li_l = ws; float* al_l = ws + 32;
    const float* bl = (const float*)(lds + OFF_BL);
    float m_reg = m_init, l_reg = l_init; f32x16 o[4] = {}; bf16x8 qr[MODE ? 12 : 8];
    const bf16_t* Qw = Qb + (long)(wid * 32 + r32) * LDP + hi * 8;
#pragma unroll
    for (int d0 = 0; d0 < 8; ++d0) qr[d0] = ld8(Qw + d0 * 16);
    char* QR_lds = lds + OFF_QR; const int qrow = wid * 32 + r32;
    const char* QRw = QR_lds + qrow * 128; const int qsw = ((qrow >> 1) & 7) << 4;
    if constexpr (MODE == 1) {
        const bf16_t* Qrw = Qrb + (long)(wid * 32 + r32) * LDP + hi * 8;
#pragma unroll
        for (int d0 = 0; d0 < 4; ++d0) qr[8 + d0] = ld8(Qrw + d0 * 16);
    }
    const int widu = __builtin_amdgcn_readfirstlane(tid >> 6);
    LAS unsigned char* l3 = (LAS unsigned char*)lds;
    const unsigned wbase = (unsigned)widu * 1024u;
    int offK, offV, offKR;
    { const int row = tid >> 4, cpos = tid & 15; offK = row * LDK + ((cpos ^ (row & 15)) * 8); }
    { const int kkhi = tid >> 7, chi = (tid >> 5) & 3, w = tid & 31, kk = kkhi * 8 + (w >> 2), k = (kk & ~0xC) | ((kk & 4) << 1) | ((kk & 8) >> 1); offV = k * LDK + chi * 32 + (w & 3) * 8; }
    { const int row = tid >> 3, cpos = tid & 7; offKR = row * LDP + ((cpos ^ ((row >> 1) & 7)) * 8); }
    const int vb0 = (int)(uintptr_t)V_lds + v_rd_base(lane);
    const int idxw = relbase - wid * 32 - r32 + 384 + 4 * hi;
#define GLDS(gptr, ldsoff) __builtin_amdgcn_global_load_lds((const unsigned*)(gptr), (LAS unsigned*)(l3 + (ldsoff)), 16, 0, 0)
#define TLOAD(kb, vb_, k0) do { const bf16_t* kg_ = Kh + (long)(k0) * LDK + offK; const bf16_t* vg_ = Vh + (long)(k0) * LDK + offV; \
    GLDS(kg_, OFF_K + (kb) * SHM_K + wbase); GLDS(kg_ + 32 * LDK, OFF_K + (kb) * SHM_K + wbase + 8192u); \
    GLDS(vg_, OFF_V + (vb_) * SHM_V + wbase); GLDS(vg_ + 32 * LDK, OFF_V + (vb_) * SHM_V + wbase + 8192u); \
    if constexpr (MODE == 1) GLDS(Krh + (long)(k0) * LDP + offKR, OFF_KR + (kb) * SHM_KR + wbase); } while (0)
#define RESC(a) do { if (__any((a) < 1.f)) { if (hi == 0) al_l[r32] = (a); asm volatile("s_waitcnt lgkmcnt(0)" ::: "memory"); \
    _Pragma("unroll") for (int d = 0; d < 4; ++d) _Pragma("unroll") for (int r = 0; r < 16; ++r) o[d][r] *= al_l[crow(r, hi)]; } } while (0)
    f32x16 p0, p1; float mn0, mn1, al0, al1; bf16x8 pa0, pa1, pa2, pa3;
    const unsigned vl0 = (unsigned)(uintptr_t)(l3 + OFF_V) + (unsigned)v_rd_base(lane);
    int vcur = 0, vnext = 1;
    TLOAD(0, 0, 0); asm volatile("s_waitcnt vmcnt(0)" ::: "memory"); __syncthreads();
    for (int j = 0; j < NT; ++j) {
        const int b = j & 1;
        if (j + 1 < NT) TLOAD(b ^ 1, vnext, (j + 1) * 64);
        const char* Ks = K_lds + b * SHM_K; const char* Krs = KR_lds + b * SHM_KR; const unsigned vl = vl0 + (unsigned)(vcur * SHM_V);
#if ATT_WHOLE_TILE
        qk_half<MODE>(p0, Ks, Krs, 0, qr, QRw, qsw, r32, hi);
        qk_half<MODE>(p1, Ks, Krs, 32, qr, QRw, qsw, r32, hi);
        partialSM<MODE>(p0, p1, m_reg, mn0, al0, bl, idxw + 64 * j);
        RESC(al0);
        finishSM(p0, p1, al0, l_reg, pa0, pa1, pa2, pa3);
        pv_half<0>(o, vl, pa0, pa1);
        pv_half<1>(o, vl, pa2, pa3);
        (void)mn1; (void)al1;
#else
        qk_half<MODE>(p0, Ks, Krs, 0, qr, QRw, qsw, r32, hi);
        half_max<MODE>(p0, m_reg, mn0, al0, bl, idxw + 64 * j);
        RESC(al0);
        qk_half<MODE>(p1, Ks, Krs, 32, qr, QRw, qsw, r32, hi);
        half_exp<MODE>(p0, mn0, al0, l_reg, pa0, pa1);
        half_max<MODE>(p1, m_reg, mn1, al1, bl, idxw + 64 * j + 32);
        pv_half<0>(o, vl, pa0, pa1);
        half_exp<MODE>(p1, mn1, al1, l_reg, pa2, pa3);
        RESC(al1);
        pv_half<1>(o, vl, pa2, pa3);
#endif
        asm volatile("s_waitcnt vmcnt(0)" ::: "memory");
        __syncthreads();
        vcur = vnext; vnext = vnext == 2 ? 0 : vnext + 1;
    }
    if (hi == 0) li_l[r32] = l_reg; asm volatile("s_waitcnt lgkmcnt(0)" ::: "memory");
    float rli[16];
#pragma unroll
    for (int r = 0; r < 16; ++r) rli[r] = __builtin_amdgcn_rcpf(li_l[crow(r, hi)]);
    __syncthreads();
    char* stg = lds + wid * 8704;
#pragma unroll
    for (int r = 0; r < 16; ++r) { const int orow = crow(r, hi);
#pragma unroll
        for (int d0 = 0; d0 < 4; ++d0) *(bf16_t*)(stg + orow * 272 + (d0 * 32 + r32) * 2) = f2bf(o[d0][r] * rli[r]); }
    asm volatile("s_waitcnt lgkmcnt(0)" ::: "memory");
    bf16_t* Ow = Ob + (long)(wid * 32 + (lane >> 4)) * LDP + (lane & 15) * 8;
    const char* srd = stg + (lane >> 4) * 272 + (lane & 15) * 16;
#pragma unroll
    for (int i = 0; i < 8; ++i) *(u32x4*)(Ow + (long)(i * 4) * LDP) = *(const u32x4*)(srd + i * 4 * 272);
#undef GLDS
#undef TLOAD
#undef RESC
}
}

__device__ __forceinline__ int win_dst_row(int n0) {
    if (n0 < 1024) return n0;
    if (n0 < 1536) return n0 + 1024;
    if (n0 < 2560) return n0 - 512;
    return n0;
}

__device__ __forceinline__ void phase0(const Params& p, unsigned char* lds_) {
    const int tid = threadIdx.x;
    bf16_t* wt_in = (bf16_t*)(p.ws + WS_WIN);
    for (int i = blockIdx.x * 512 + tid; i < 192 * DM * 2 / 16; i += gridDim.x * 512) ((u32x4*)(wt_in + (size_t)3648 * DM))[i] = (u32x4){0u, 0u, 0u, 0u};
    float* tile = (float*)lds_;
    constexpr int T_IN = 32 * 57, T_KVB = 8 * 32, T_O = 32 * 32, T_FF1 = 32 * 128, T_FF2 = 128 * 32, T_ALL = T_IN + T_KVB + T_O + T_FF1 + T_FF2;
    for (int t = blockIdx.x; t < T_ALL; t += gridDim.x) {
        const float* src; bf16_t* dst; int K, N, tt = t; bool isin = false;
        if (tt < T_IN) { src = p.w_in; dst = wt_in; K = 2048; N = 3648; isin = true; }
        else if ((tt -= T_IN) < T_KVB) { src = p.w_kv_b; dst = (bf16_t*)(p.ws + WS_WKVB); K = 512; N = 2048; }
        else if ((tt -= T_KVB) < T_O) { src = p.w_o; dst = (bf16_t*)(p.ws + WS_WO); K = 2048; N = 2048; }
        else if ((tt -= T_O) < T_FF1) { src = p.w_ff1; dst = (bf16_t*)(p.ws + WS_WFF1); K = 2048; N = 8192; }
        else { tt -= T_FF1; src = p.w_ff2; dst = (bf16_t*)(p.ws + WS_WFF2); K = 8192; N = 2048; }
        const int nkt = K / 64, kt = tt % nkt, nti = tt / nkt, k0 = kt * 64, n0 = nti * 64;
        const int d0 = isin ? win_dst_row(n0) : n0;
        { const int r = tid >> 4, c4 = tid & 15;
#pragma unroll
          for (int i = 0; i < 2; ++i) { const int k = r + 32 * i; const f32x4 v = *(const f32x4*)(src + (size_t)(k0 + k) * N + n0 + c4 * 4);
              tile[k * 65 + c4 * 4 + 0] = v[0]; tile[k * 65 + c4 * 4 + 1] = v[1]; tile[k * 65 + c4 * 4 + 2] = v[2]; tile[k * 65 + c4 * 4 + 3] = v[3]; } }
        __syncthreads();
        { const int n = tid >> 3, kc = tid & 7; float v[8];
#pragma unroll
          for (int j = 0; j < 8; ++j) v[j] = tile[(kc * 8 + j) * 65 + n];
          u32x4 w; w.x = cvt_pk_bf16(v[0], v[1]); w.y = cvt_pk_bf16(v[2], v[3]); w.z = cvt_pk_bf16(v[4], v[5]); w.w = cvt_pk_bf16(v[6], v[7]);
          *(u32x4*)(dst + (size_t)(d0 + n) * K + k0 + kc * 8) = w; }
        __syncthreads();
    }
    float* sl = (float*)lds_;
    float* red = sl + 9 * 2048;
    for (int i = tid; i < 9 * 2048; i += 512) { const float v = i < 8 * 2048 ? p.c_prompt[i] : p.c_sample[i - 8 * 2048]; sl[i] = v / (1.f + __expf(-v)); }
    __syncthreads();
    float* mod = (float*)(p.ws + WS_MOD);
    for (int cgp = blockIdx.x; cgp < 256; cgp += gridDim.x) {
        if (tid < 384) {
            const int cq = tid % 12, kg = tid / 12, j0 = cgp * 48 + cq * 4;
            f32x4 acc[9];
#pragma unroll
            for (int b = 0; b < 9; ++b) acc[b] = (f32x4){0.f, 0.f, 0.f, 0.f};
#pragma unroll 8
            for (int k = kg * 64; k < kg * 64 + 64; ++k) { const f32x4 w = *(const f32x4*)(p.w_ada + (size_t)k * MODW + j0);
#pragma unroll
                for (int b = 0; b < 9; ++b) acc[b] += sl[b * 2048 + k] * w; }
#pragma unroll
            for (int b = 0; b < 9; ++b)
#pragma unroll
                for (int e = 0; e < 4; ++e) red[(kg * 9 + b) * 48 + cq * 4 + e] = acc[b][e];
        }
        __syncthreads();
        for (int i = tid; i < 432; i += 512) { const int b = i / 48, j = i % 48; float s = p.b_ada[cgp * 48 + j];
            for (int kg = 0; kg < 32; ++kg) s += red[(kg * 9 + b) * 48 + j];
            mod[b * MODW + cgp * 48 + j] = s; }
        __syncthreads();
    }
}

template <int KIND>
__device__ __forceinline__ void rows_norm(const Params& p, bf16_t* dst) {
    const int wid = threadIdx.x >> 6, lane = threadIdx.x & 63;
    const float* mod = (const float*)(p.ws + WS_MOD);
    const float* g = KIND == 0 ? p.g_mix : (KIND == 1 ? p.g_mlp : p.g_final);
    for (int grp = blockIdx.x * 8 + wid; grp < NTOK / 16; grp += gridDim.x * 8) {
        const int rbase = grp * 16; const int batch = rbase < NPROMPT ? (rbase >> 11) : 8;
        const float* mb = mod + (size_t)batch * MODW + (KIND == 0 ? 0 : 3 * DM);
        f32x4 mv[8], sv[8];
#pragma unroll
        for (int i = 0; i < 8; ++i) { const int col = i * 256 + lane * 4; mv[i] = *(const f32x4*)(g + col);
            if (KIND < 2) { mv[i] = mv[i] * (1.f + *(const f32x4*)(mb + DM + col)); sv[i] = *(const f32x4*)(mb + col); } else sv[i] = (f32x4){0.f, 0.f, 0.f, 0.f}; }
#pragma unroll 1
        for (int r2 = 0; r2 < 8; ++r2) {
            f32x4 v[2][8];
#pragma unroll
            for (int h = 0; h < 2; ++h) { const int row = rbase + 2 * r2 + h;
                const float* src = KIND == 0 ? (row < NPROMPT ? p.x_prompt + (size_t)row * DM : p.x_sample + (size_t)(row - NPROMPT) * DM) : p.out + (size_t)row * DM;
#pragma unroll
                for (int i = 0; i < 8; ++i) v[h][i] = *(const f32x4*)(src + i * 256 + lane * 4); }
#pragma unroll
            for (int h = 0; h < 2; ++h) { const int row = rbase + 2 * r2 + h;
                float ss = 0.f;
#pragma unroll
                for (int i = 0; i < 8; ++i) ss += v[h][i][0] * v[h][i][0] + v[h][i][1] * v[h][i][1] + v[h][i][2] * v[h][i][2] + v[h][i][3] * v[h][i][3];
                ss = wave_sum(ss);
                const float rstd = rsqrtf(ss * (1.f / DM) + EPS);
#pragma unroll
                for (int i = 0; i < 8; ++i) { const int col = i * 256 + lane * 4; const f32x4 y = v[h][i] * rstd * mv[i] + sv[i];
                    if (KIND < 2) { u32x2 w; w.x = cvt_pk_bf16(y[0], y[1]); w.y = cvt_pk_bf16(y[2], y[3]); *(u32x2*)(dst + (size_t)row * DM + col) = w; }
                    else *(f32x4*)(p.out + (size_t)row * DM + col) = y; } }
        }
    }
}

__device__ __forceinline__ void phase1_side(const Params& p, unsigned char* lds_) {
    const int wid = threadIdx.x >> 6, lane = threadIdx.x & 63;
    float* ss2 = (float*)(p.ws + WS_SS2);
    for (int i = blockIdx.x * 512 + threadIdx.x; i < NTOK; i += gridDim.x * 512) ss2[i] = 0.f;
    const float* mod = (const float*)(p.ws + WS_MOD); const bf16_t* w1t = (const bf16_t*)(p.ws + WS_WFF1); float* b2 = (float*)(p.ws + WS_B2);
    float* sl = (float*)lds_;
    for (int i = threadIdx.x; i < 9 * DM / 4; i += 512) { const int b = i / (DM / 4), k4 = i % (DM / 4); *(f32x4*)(sl + b * DM + k4 * 4) = *(const f32x4*)(mod + (size_t)b * MODW + 3 * DM + k4 * 4); }
    __syncthreads();
    for (int n = blockIdx.x * 8 + wid; n < DFF; n += gridDim.x * 8) {
        float w[32];
#pragma unroll
        for (int i = 0; i < 4; ++i) { const u32x4 v = *(const u32x4*)(w1t + (size_t)n * DM + i * 512 + lane * 8);
#pragma unroll
            for (int j = 0; j < 4; ++j) { w[i * 8 + 2 * j] = __uint_as_float(v[j] << 16); w[i * 8 + 2 * j + 1] = __uint_as_float(v[j] & 0xffff0000u); } }
        float acc[9];
#pragma unroll
        for (int b = 0; b < 9; ++b) { float a = 0.f;
#pragma unroll
            for (int i = 0; i < 4; ++i) { const f32x4 s0 = *(const f32x4*)(sl + b * DM + i * 512 + lane * 8), s1 = *(const f32x4*)(sl + b * DM + i * 512 + lane * 8 + 4);
                a += s0[0] * w[i * 8] + s0[1] * w[i * 8 + 1] + s0[2] * w[i * 8 + 2] + s0[3] * w[i * 8 + 3] + s1[0] * w[i * 8 + 4] + s1[1] * w[i * 8 + 5] + s1[2] * w[i * 8 + 6] + s1[3] * w[i * 8 + 7]; }
            acc[b] = a; asm volatile("" ::: "memory"); }
#pragma unroll
        for (int b = 0; b < 9; ++b) acc[b] = wave_sum(acc[b]);
        if (lane == 0) {
#pragma unroll
            for (int b = 0; b < 9; ++b) b2[(size_t)b * DFF + n] = acc[b]; }
    }
    __syncthreads();
}

__device__ __forceinline__ void phase_rope(const Params& p) {
    const int wid = threadIdx.x >> 6, lane = threadIdx.x & 63, i32 = lane & 31;
    bf16_t* proj = (bf16_t*)(p.ws + WS_PROJ);
    const double inv = exp2(-(double)i32 * (13.287712379549449 / 32.0));
    f32x4 g0 = *(const f32x4*)(p.g_kv + lane * 8), g1 = *(const f32x4*)(p.g_kv + lane * 8 + 4);
    const int stride = gridDim.x * 8;
    for (int t0 = blockIdx.x * 8 + wid; t0 < NTOK; t0 += 2 * stride) {
        float qa[2][4], qb[2][4], ka[2], kb[2]; u32x4 cv[2];
#pragma unroll
        for (int h = 0; h < 2; ++h) { const int t = t0 + h * stride; if (t < NTOK) { const bf16_t* row = proj + (size_t)t * LDP;
#pragma unroll
            for (int j = 0; j < 4; ++j) { const bf16_t* q = row + C_QR + (2 * j + (lane >> 5)) * 64 + i32; qa[h][j] = bf2f(q[0]); qb[h][j] = bf2f(q[32]); }
            { const bf16_t* q = row + C_KR + i32; ka[h] = bf2f(q[0]); kb[h] = bf2f(q[32]); }
            cv[h] = *(const u32x4*)(row + C_CKV + lane * 8); } }
#pragma unroll
        for (int h = 0; h < 2; ++h) { const int t = t0 + h * stride; if (t < NTOK) {
            const int pos = t < NPROMPT ? (t & (SEQP - 1)) : t - NPROMPT;
            bf16_t* row = proj + (size_t)t * LDP;
            double a = (double)pos * inv; a -= 6.283185307179586 * rint(a * 0.15915494309189535);
            const float af = (float)a, sn = sinf(af), cs = cosf(af);
#pragma unroll
            for (int j = 0; j < 4; ++j) { bf16_t* q = row + C_QR + (2 * j + (lane >> 5)) * 64 + i32; const float x1 = qa[h][j], x2 = qb[h][j];
                q[0] = f2bf(x1 * cs - x2 * sn); q[32] = f2bf(x1 * sn + x2 * cs); }
            if (lane < 32) { bf16_t* q = row + C_KR + i32; const float x1 = ka[h], x2 = kb[h]; q[0] = f2bf(x1 * cs - x2 * sn); q[32] = f2bf(x1 * sn + x2 * cs); }
            float x[8];
#pragma unroll
            for (int j = 0; j < 4; ++j) { x[2 * j] = __uint_as_float(cv[h][j] << 16); x[2 * j + 1] = __uint_as_float(cv[h][j] & 0xffff0000u); }
            float ss = 0.f;
#pragma unroll
            for (int j = 0; j < 8; ++j) ss += x[j] * x[j];
            ss = wave_sum(ss);
            const float rstd = rsqrtf(ss * (1.f / 512.f) + EPS);
            u32x4 w; w.x = cvt_pk_bf16(x[0] * rstd * g0[0], x[1] * rstd * g0[1]); w.y = cvt_pk_bf16(x[2] * rstd * g0[2], x[3] * rstd * g0[3]);
            w.z = cvt_pk_bf16(x[4] * rstd * g1[0], x[5] * rstd * g1[1]); w.w = cvt_pk_bf16(x[6] * rstd * g1[2], x[7] * rstd * g1[3]);
            *(u32x4*)(row + C_CKV + lane * 8) = w; } }
    }
}

__device__ __forceinline__ int t5_bucket(int rel) {
    const int n = rel < 0 ? -rel : rel; int b;
    if (n < 8) b = n; else if (n < 12) b = 8; else if (n < 16) b = 9; else if (n < 23) b = 10; else if (n < 32) b = 11; else if (n < 46) b = 12; else if (n < 64) b = 13; else if (n < 91) b = 14; else b = 15;
    return b + (rel > 0 ? 16 : 0);
}

#ifndef NB_ITEMS
#define NB_ITEMS 1024
#endif
#ifndef NA_ITEMS
#define NA_ITEMS 1024
#endif
__device__ __forceinline__ void phase_attn(const Params& p, char* lds, int vbid) {
    bf16_t* proj = (bf16_t*)(p.ws + WS_PROJ); const bf16_t* kvb = (const bf16_t*)(p.ws + WS_R2);
    const int G = gridDim.x, bid = vbid;
#ifdef ATT_TWICE
    for (int rep = 0; rep < 2; ++rep) {
    bf16_t* oproj = rep == 0 ? (bf16_t*)p.out : proj;
#else
    bf16_t* oproj = proj;
    {
#endif
    for (int it = bid; it < NB_ITEMS; it += G) {
        const int h = it & 7; int row0, kbase, S;
        if (it < 512) { const int qb = it >> 3; row0 = NPROMPT + qb * 256; kbase = NPROMPT; S = SEQS; }
        else { const int r = (it - 512) >> 3; const int seq = r >> 3, qb = r & 7; row0 = seq * SEQP + qb * 256; kbase = seq * SEQP; S = SEQP; }
        __syncthreads();
        bf16_t* Qb = proj + (size_t)row0 * LDP + C_QN + h * 128;
        att::attn_item<1>(Qb, proj + (size_t)row0 * LDP + C_QR + h * 64, kvb + (size_t)kbase * 2048 + h * 256, proj + (size_t)kbase * LDP + C_KR,
                          kvb + (size_t)kbase * 2048 + h * 256 + 128, oproj + (size_t)row0 * LDP + C_QN + h * 128, S / 64, 0, -1e30f, 0.f, lds);
    }
    float* bl = (float*)(lds + att::OFF_BL);
    for (int it = bid; it < NA_ITEMS; it += G) {
        const int h = it & 7, kvh = h >> 2, row0 = (it >> 3) * 256;
        const int seq0 = row0 < NPROMPT ? (row0 & ~(SEQP - 1)) : NPROMPT, S = row0 < NPROMPT ? SEQP : SEQS, pos0 = row0 - seq0;
        const int kf = pos0 - 128 < 0 ? 0 : pos0 - 128, kl = pos0 + 384 > S ? S : pos0 + 384;
        __syncthreads();
        for (int i = threadIdx.x; i < 768; i += 512) { const int rel = i - 384; bl[i] = (rel >= -128 && rel <= 128) ? p.rel_bias[t5_bucket(rel) * 8 + h] * LOG2E : -1e30f; }
        bf16_t* Qb = proj + (size_t)row0 * LDP + C_QA + h * 128;
        att::attn_item<0>(Qb, nullptr, proj + (size_t)(seq0 + kf) * LDP + C_KA + kvh * 128, nullptr, proj + (size_t)(seq0 + kf) * LDP + C_VA + kvh * 128, oproj + (size_t)row0 * LDP + C_QA + h * 128,
                          (kl - kf) / 64, kf - pos0, p.sink[h] * LOG2E, 1.f, lds);
    }
    }
}

__global__ void __launch_bounds__(512) fwd_mega(Params p) {
    extern __shared__ __attribute__((aligned(16))) unsigned char lds[];
    cg::grid_group grid = cg::this_grid();
    const int lo = p.ph_lo, hi = p.ph_hi;
#ifndef PH_MASK
#define PH_MASK 0x1ffff
#endif
#define IN(k) (((PH_MASK >> (k)) & 1) && lo <= (k) && (k) < hi)
#define SEAM(k) do { if (IN(k) && IN((k) + 1)) { if (p.coop == 2) grid.sync(); else xcd_barrier(xbar); } } while (0)
    { volatile LAS unsigned* st = (volatile LAS unsigned*)((LAS unsigned char*)lds + LDS_XB); if (threadIdx.x == 0) { st[0] = 0u; st[1] = 0u; st[2] = 0u; st[3] = 0u; } }
    __syncthreads();
    XcdBarrier xbar = xcd_barrier_post((unsigned*)(p.ws + WS_BAR), (volatile LAS unsigned*)((LAS unsigned char*)lds + LDS_XB));
    bf16_t* proj = (bf16_t*)(p.ws + WS_PROJ); bf16_t* r2 = (bf16_t*)(p.ws + WS_R2);
    const float* mod = (const float*)(p.ws + WS_MOD);
    LAS unsigned char* l3 = (LAS unsigned char*)lds;

    if (IN(0)) phase0(p, lds);
    SEAM(0);
    int vbid = blockIdx.x;
    if (IN(0) && IN(1)) {
        volatile LAS unsigned* st = (volatile LAS unsigned*)((LAS unsigned char*)lds + LDS_XB);
        if (threadIdx.x == 0) { unsigned* bar = (unsigned*)(p.ws + WS_BAR); const unsigned G = gridDim.x; bool ok = (G % 8u) == 0u;
            for (unsigned j = 0; j < 16; ++j) { const unsigned cnt = xb_ld(&bar[XB_XCNT(j)]); ok = ok && (j < 8 ? cnt == G / 8u : cnt == 0u); }
            st[3] = ok ? (st[2] * 8u + xbar.x) : (unsigned)blockIdx.x; }
        __syncthreads();
        vbid = (int)st[3];
    }
#ifdef XTRA_SYNC
    for (int e = 0; e < XTRA_SYNC; ++e) grid.sync();
#endif
    if (IN(1)) { phase1_side(p, lds); rows_norm<0>(p, r2); }
    SEAM(1);
    if (IN(2)) { pg8::Gemm g{r2, DM, (const bf16_t*)(p.ws + WS_WIN), NTOK, LDP, DM}; pg8::StaticOrder S; S.init(NTOK, LDP, gridDim.x, vbid);
        pg8::EpiBf16<0> E{proj, LDP}; pg8::gemm_phase(l3, g, S, E); }
    SEAM(2);
    if (IN(3)) phase_rope(p);
    SEAM(3);
    if (IN(4)) { pg8::Gemm g{proj + C_CKV, LDP, (const bf16_t*)(p.ws + WS_WKVB), NTOK, 2048, 512}; pg8::StaticOrder S; S.init(NTOK, 2048, gridDim.x, vbid);
        pg8::EpiBf16<0> E{r2, 2048}; pg8::gemm_phase(l3, g, S, E); }
    SEAM(4);
    if (IN(5)) phase_attn(p, (char*)lds, vbid);
    SEAM(5);
    if (IN(6)) { pg8::Gemm g{proj, LDP, (const bf16_t*)(p.ws + WS_WO), NTOK, DM, DM}; pg8::StaticOrder S; S.init(NTOK, DM, gridDim.x, vbid);
        pg8::EpiWo E{p.x_prompt, p.x_sample, p.out, mod, p.g_mlp, r2, (float*)(p.ws + WS_SS2)}; pg8::gemm_phase(l3, g, S, E); }
    SEAM(6);
    const bool fuse_final = (gridDim.x == 256) && (hi - lo == NPHASE);
#pragma unroll 1
    for (int c = 0; c < 4; ++c) {
        if (IN(8 + 2 * c)) { pg8::Gemm g{r2 + (size_t)c * FCH * DM, DM, (const bf16_t*)(p.ws + WS_WFF1), FCH, DFF, DM}; pg8::StaticOrder S; S.init(FCH, DFF, gridDim.x, vbid);
            pg8::EpiFfn1 E{proj, (const float*)(p.ws + WS_SS2), (const float*)(p.ws + WS_B2), c * FCH}; pg8::gemm_phase(l3, g, S, E); }
        SEAM(8 + 2 * c);
        if (IN(9 + 2 * c)) { pg8::Gemm g{proj, DFF, (const bf16_t*)(p.ws + WS_WFF2), FCH, DM, DFF};   pg8::StaticOrder S; S.init(FCH, DM, gridDim.x, vbid);
            if (fuse_final) { pg8::EpiFinal E{p.out, mod + 5 * DM, p.g_final, (float*)(p.ws + WS_SS), c * FCH, xbar}; pg8::gemm_phase(l3, g, S, E); }
            else { pg8::EpiResGate E{p.out, p.out + (size_t)NPROMPT * DM, p.out, mod + 5 * DM, c * FCH}; pg8::gemm_phase(l3, g, S, E); } }
        if (!fuse_final) SEAM(9 + 2 * c);
    }
    if (IN(16) && !fuse_final) rows_norm<2>(p, nullptr);
#undef IN
#undef SEAM
}

#ifndef N_LAUNCHES
#define N_LAUNCHES 1
#endif
extern "C" void kernel_launch(void* const* d_in, const int* in_sizes, int n_in, void* d_out, int out_size, void* d_ws, size_t ws_size, hipStream_t stream) {
    static int grid = 0;
    if (grid == 0) {
        if (n_in != 17 || ws_size < WS_END) { fprintf(stderr, "kernel_launch: n_in %d ws %zu (need %zu)\n", n_in, ws_size, (size_t)WS_END); grid = -1; return; }
        int dev = 0, cus = 0, per_cu = 0;
        hipGetDevice(&dev); hipDeviceGetAttribute(&cus, hipDeviceAttributeMultiprocessorCount, dev);
        if (hipFuncSetAttribute((const void*)fwd_mega, hipFuncAttributeMaxDynamicSharedMemorySize, LDS_BYTES) != hipSuccess) { fprintf(stderr, "kernel_launch: hipFuncSetAttribute failed\n"); grid = -1; return; }
        if (hipOccupancyMaxActiveBlocksPerMultiprocessor(&per_cu, (const void*)fwd_mega, 512, LDS_BYTES) != hipSuccess || per_cu < 1) { fprintf(stderr, "kernel_launch: occupancy query says %d\n", per_cu); per_cu = 1; }
        (void)hipGetLastError();
        grid = cus * 1;
        fprintf(stderr, "kernel_launch: cus %d per_cu %d grid %d ws %zu\n", cus, per_cu, grid, ws_size);
    }
    if (grid < 0) return;
    Params p{};
    p.x_prompt = (const float*)d_in[0]; p.x_sample = (const float*)d_in[1]; p.c_prompt = (const float*)d_in[2]; p.c_sample = (const float*)d_in[3];
    p.w_ada = (const float*)d_in[4]; p.b_ada = (const float*)d_in[5]; p.g_mix = (const float*)d_in[6]; p.w_in = (const float*)d_in[7]; p.sink = (const float*)d_in[8];
    p.g_kv = (const float*)d_in[9]; p.w_kv_b = (const float*)d_in[10]; p.w_o = (const float*)d_in[11]; p.g_mlp = (const float*)d_in[12]; p.w_ff1 = (const float*)d_in[13];
    p.w_ff2 = (const float*)d_in[14]; p.rel_bias = (const float*)d_in[15]; p.g_final = (const float*)d_in[16];
    p.out = (float*)d_out; p.ws = (unsigned char*)d_ws;
#if N_LAUNCHES == 1
    (void)hipMemsetAsync((char*)d_ws + WS_BAR, 0, 16384, stream);
    p.ph_lo = 0; p.ph_hi = NPHASE; p.coop = 1;
    void* args[] = {&p};
    hipError_t e = hipLaunchCooperativeKernel((void*)fwd_mega, dim3(grid), dim3(512), args, LDS_BYTES, stream);
    if (e != hipSuccess) fprintf(stderr, "cooperative launch failed: %s (grid %d)\n", hipGetErrorString(e), grid);
#else
    for (int k = 0; k < NPHASE; ++k) { p.ph_lo = k; p.ph_hi = k + 1; p.coop = 0;
        hipLaunchKernelGGL(fwd_mega, dim3(grid), dim3(512), LDS_BYTES, stream, p); }
#endif
}
```

```cpp
#include <hip/hip_runtime.h>
#include <hip/hip_cooperative_groups.h>
#include <cstdio>
#include <cstdint>
namespace cg = cooperative_groups;

#define LAS __attribute__((address_space(3)))
typedef unsigned short bf16_t;
typedef short bf16x8 __attribute__((ext_vector_type(8)));
typedef short s16x4 __attribute__((ext_vector_type(4)));
typedef float f32x4 __attribute__((ext_vector_type(4)));
typedef float f32x2 __attribute__((ext_vector_type(2)));
typedef float f32x16 __attribute__((ext_vector_type(16)));
typedef unsigned u32x4 __attribute__((ext_vector_type(4)));
typedef unsigned u32x2 __attribute__((ext_vector_type(2)));

constexpr int DM = 2048, NTOK = 32768, NPROMPT = 16384, SEQP = 2048, SEQS = 16384, DFF = 8192;
constexpr int LDP = 3840;
constexpr int C_QA = 0, C_QN = 1024, C_KA = 2048, C_VA = 2304, C_QR = 2560, C_CKV = 3072, C_KR = 3584;
constexpr int MODW = 6 * DM;
constexpr int FCH = 8192;
constexpr float EPS = 1e-6f;
constexpr float LOG2E = 1.4426950408889634f;

constexpr size_t WS_WIN = 0;
constexpr size_t WS_WKVB = WS_WIN + (size_t)LDP * DM * 2;
constexpr size_t WS_WO = WS_WKVB + (size_t)2048 * 512 * 2;
constexpr size_t WS_WFF1 = WS_WO + (size_t)DM * DM * 2;
constexpr size_t WS_WFF2 = WS_WFF1 + (size_t)DFF * DM * 2;
constexpr size_t WS_MOD = WS_WFF2 + (size_t)DM * DFF * 2;
constexpr size_t WS_PROJ = WS_MOD + (size_t)9 * MODW * 4 + 1024;
constexpr size_t WS_R2 = WS_PROJ + (size_t)NTOK * LDP * 2;
constexpr size_t WS_BAR = WS_R2 + (size_t)NTOK * DM * 2;
constexpr size_t WS_SS = WS_BAR + 16384;
constexpr size_t WS_SS2 = WS_SS + (size_t)NTOK * 8 * 4;
constexpr size_t WS_B2 = WS_SS2 + (size_t)NTOK * 4;
constexpr size_t WS_END = WS_B2 + (size_t)9 * DFF * 4;
constexpr int LDS_XB = 139264;
constexpr int LDS_BYTES = 139264 + 256;
constexpr int NPHASE = 17;

struct Params {
    const float* x_prompt; const float* x_sample; const float* c_prompt; const float* c_sample;
    const float* w_ada; const float* b_ada; const float* g_mix; const float* w_in; const float* sink;
    const float* g_kv; const float* w_kv_b; const float* w_o; const float* g_mlp; const float* w_ff1; const float* w_ff2;
    const float* rel_bias; const float* g_final;
    float* out; unsigned char* ws;
    int ph_lo, ph_hi, coop, pad;
};

__device__ __forceinline__ unsigned cvt_pk_bf16(float lo, float hi) { unsigned r; asm volatile("v_cvt_pk_bf16_f32 %0, %1, %2" : "=v"(r) : "v"(lo), "v"(hi)); return r; }
typedef __bf16 bf16x2_t __attribute__((ext_vector_type(2)));
__device__ __forceinline__ unsigned cvt_pk_nv(float lo, float hi) { f32x2 v = {lo, hi}; bf16x2_t c = __builtin_convertvector(v, bf16x2_t); return *reinterpret_cast<unsigned*>(&c); }
__device__ __forceinline__ float bf2f(bf16_t b) { return __uint_as_float(((unsigned)b) << 16); }
__device__ __forceinline__ bf16_t f2bf(float f) { return (bf16_t)(cvt_pk_bf16(f, 0.f) & 0xffffu); }
__device__ __forceinline__ float wave_sum(float v) {
#pragma unroll
    for (int o = 32; o >= 1; o >>= 1) v += __shfl_xor(v, o);
    return v;
}

#define XB_TMO      128
#define XB_XCNT(j)  (256  + 64 * (j))
#define XB_XSUB(j)  (1280 + 64 * (j))
#define XB_XGEN(j)  (2304 + 64 * (j))
#define XB_TOP      3328
#define XB_TOPGEN   3392
#define XCD_BAR_WORDS 3456
#define XB_SPIN_CAP (1u << 20)
__device__ __forceinline__ unsigned xb_ld(unsigned* p)              { return __hip_atomic_load(p, __ATOMIC_RELAXED, __HIP_MEMORY_SCOPE_AGENT); }
__device__ __forceinline__ unsigned xb_add(unsigned* p, unsigned v) { return __hip_atomic_fetch_add(p, v, __ATOMIC_RELAXED, __HIP_MEMORY_SCOPE_AGENT); }
__device__ __forceinline__ unsigned xb_xcc_id() { return (unsigned)__builtin_amdgcn_s_getreg((3 << 11) | 20) & 0xFu; }
#define XB_SPIN(cond, bar) do { unsigned _sp = 0; while (cond) { __builtin_amdgcn_s_sleep(1); \
    if ((++_sp & 255u) == 0u) { if (xb_ld(&(bar)[XB_TMO])) break; if (_sp > XB_SPIN_CAP) { atomicAdd(&(bar)[XB_TMO], 1u); break; } } } } while (0)
struct XcdBarrier { unsigned* bar; unsigned x; volatile LAS unsigned* st; };
__device__ __forceinline__ XcdBarrier xcd_barrier_post(unsigned* bar, volatile LAS unsigned* st) {
    XcdBarrier b; b.bar = bar; b.x = xb_xcc_id(); b.st = st;
    if (threadIdx.x == 0) st[2] = xb_add(&bar[XB_XCNT(b.x)], 1u);
    return b;
}
__device__ __forceinline__ void xcd_barrier_complete(unsigned* bar, unsigned x, unsigned& nloc, unsigned& nx) {
    const unsigned G = gridDim.x * gridDim.y * gridDim.z;
    unsigned sum, cnt, mine, sp = 0u;
    for (;;) {
        sum = 0u; cnt = 0u; mine = 0u;
#pragma unroll
        for (unsigned j = 0; j < 16; ++j) { const unsigned c = xb_ld(&bar[XB_XCNT(j)]); sum += c; cnt += (c > 0u) ? 1u : 0u; mine = (j == x) ? c : mine; }
        if (sum == G) break;
        __builtin_amdgcn_s_sleep(1);
        if ((++sp & 255u) == 0u) { if (xb_ld(&bar[XB_TMO])) break; if (sp > XB_SPIN_CAP) { atomicAdd(&bar[XB_TMO], 1u); break; } }
    }
    nloc = mine > 0u ? mine : 1u; nx = cnt > 0u ? cnt : 1u;
}
__device__ __forceinline__ void xcd_barrier(const XcdBarrier& b) {
    asm volatile("s_waitcnt vmcnt(0)" ::: "memory");
    __syncthreads();
    if (threadIdx.x == 0) {
        unsigned* bar = b.bar;
        __builtin_amdgcn_s_waitcnt(0);
        unsigned nloc = b.st[0], nx = b.st[1];
        if (nloc == 0u) { xcd_barrier_complete(bar, b.x, nloc, nx); b.st[0] = nloc; b.st[1] = nx; }
        const unsigned old = xb_add(&bar[XB_XSUB(b.x)], 1u);
        const unsigned gen = old / nloc;
        if (old + 1u == (gen + 1u) * nloc) {
            __builtin_amdgcn_fence(__ATOMIC_RELEASE, "agent");
            asm volatile("s_waitcnt vmcnt(0)" ::: "memory");
            const unsigned og = xb_add(&bar[XB_TOP], 1u);
            const unsigned tg = og / nx;
            if (og + 1u == (tg + 1u) * nx) xb_add(&bar[XB_TOPGEN], 1u);
            else XB_SPIN(xb_ld(&bar[XB_TOPGEN]) == tg, bar);
            __builtin_amdgcn_fence(__ATOMIC_ACQUIRE, "agent");
            xb_add(&bar[XB_XGEN(b.x)], 1u);
            asm volatile("s_waitcnt vmcnt(0)" ::: "memory");
        } else {
            XB_SPIN(xb_ld(&bar[XB_XGEN(b.x)]) == gen, bar);
            __builtin_amdgcn_fence(__ATOMIC_ACQUIRE, "agent");
            asm volatile("s_waitcnt vmcnt(0)" ::: "memory");
        }
    }
    __syncthreads();
}


namespace pg8 {
constexpr int BM = 256, BK = 64, HALF = 128, HTB = HALF * BK * 2, STAGE_BYTES = 8 * HTB, NXCD = 8, WGM = 8;
__host__ __device__ __forceinline__ int lds_byte(int r, int c) { const int st = (r >> 4) * 2 + (c >> 5), rr = r & 15, cc = c & 31, ob = rr * 64 + cc * 2; return st * 1024 + (ob ^ (((ob >> 9) & 1) << 5)); }
__host__ __device__ __forceinline__ void stage_rc(int b, int& R, int& C) { const int st = b / 1024, sb = b % 1024, swz = sb ^ (((sb >> 9) & 1) << 5); R = (st >> 1) * 16 + swz / 64; C = (st & 1) * 32 + (swz % 64) / 2; }
__host__ __device__ __forceinline__ int perm32(int rho) { const int n = rho >> 4, i = rho & 15; return 8 * (i >> 2) + 4 * n + (i & 3); }

struct Unit { int pm, pn; };
struct Gemm { const bf16_t* A; int lda; const bf16_t* Bt; int M, N, K; };

struct StaticOrder {
    int nM, nN, nwg, G, c;
    __device__ void init(int M, int N, int G_, int c_) { nM = M / BM; nN = N / BM; nwg = nM * nN; G = G_; c = c_; }
    __device__ bool next(int i, Unit& u) const {
        const long L = (long)i * G + c; if (L >= nwg) return false;
        int wgid = (int)L; { const int q = nwg / NXCD, r = nwg % NXCD, xcd = wgid % NXCD, off = wgid / NXCD; wgid = (xcd < r ? xcd * (q + 1) : r * (q + 1) + (xcd - r) * q) + off; }
        const int nig = WGM * nN, gid = wgid / nig, fm = gid * WGM, gsz = (nM - fm) < WGM ? (nM - fm) : WGM;
        u.pm = fm + ((wgid % nig) % gsz); u.pn = (wgid % nig) / gsz; return true;
    }
};

template <int ACT  > struct EpiBf16 {
    static constexpr bool PERM = true, AFTER_DRAIN = false;
    bf16_t* O; int ldc;
    __device__ __forceinline__ void operator()(const f32x4 (&acc)[2][2][4][2], const Unit& u, int wr, int wc, int fr, int fq) const {
        const int row0 = u.pm * BM + wr * 64 + fr; const int col0 = u.pn * BM + wc * 32 + 8 * fq;
#pragma unroll
        for (int ai = 0; ai < 2; ++ai)
#pragma unroll
            for (int m = 0; m < 4; ++m) { bf16_t* rowp = O + (size_t)(row0 + ai * HALF + m * 16) * ldc + col0;
#pragma unroll
                for (int bj = 0; bj < 2; ++bj) { f32x4 v0 = acc[ai][bj][m][0], v1 = acc[ai][bj][m][1];
                    if (ACT == 3) {
#pragma unroll
                        for (int j = 0; j < 4; ++j) { const float a = fmaxf(v0[j], 0.f), b = fmaxf(v1[j], 0.f); v0[j] = a * a; v1[j] = b * b; } }
                    u32x4 w; w.x = cvt_pk_bf16(v0[0], v0[1]); w.y = cvt_pk_bf16(v0[2], v0[3]); w.z = cvt_pk_bf16(v1[0], v1[1]); w.w = cvt_pk_bf16(v1[2], v1[3]);
                    *(u32x4*)(rowp + bj * HALF) = w; } }
    }
};
struct EpiResGate {
    static constexpr bool PERM = false, AFTER_DRAIN = false;
    const float* xa; const float* xb; float* out; const float* gate; int row_off;
    __device__ __forceinline__ void operator()(const f32x4 (&acc)[2][2][4][2], const Unit& u, int wr, int wc, int fr, int fq) const {
        const int trow = row_off + u.pm * BM; const int batch = trow < NPROMPT ? (trow >> 11) : 8;
        const int row0 = trow + wr * 64 + fr, col0 = u.pn * BM + wc * 32 + 4 * fq;
        const float* gp = gate + (size_t)batch * MODW + col0;
        f32x4 gv[2][2];
#pragma unroll
        for (int bj = 0; bj < 2; ++bj)
#pragma unroll
            for (int n = 0; n < 2; ++n) gv[bj][n] = *(const f32x4*)(gp + bj * HALF + n * 16);
#pragma unroll
        for (int ai = 0; ai < 2; ++ai)
#pragma unroll
            for (int m = 0; m < 4; ++m) { const int row = row0 + ai * HALF + m * 16;
                const float* src = (row < NPROMPT ? xa + (size_t)row * DM : xb + (size_t)(row - NPROMPT) * DM) + col0; float* dst = out + (size_t)row * DM + col0;
#pragma unroll
                for (int bj = 0; bj < 2; ++bj)
#pragma unroll
                    for (int n = 0; n < 2; ++n) { const f32x4 b = *(const f32x4*)(src + bj * HALF + n * 16); *(f32x4*)(dst + bj * HALF + n * 16) = b + gv[bj][n] * acc[ai][bj][m][n]; } }
    }
};

struct EpiWo {
    static constexpr bool PERM = false, AFTER_DRAIN = false;
    const float* xa; const float* xb; float* out; const float* mod; const float* gmlp; bf16_t* U; float* ss2;
    __device__ __forceinline__ void operator()(const f32x4 (&acc)[2][2][4][2], const Unit& u, int wr, int wc, int fr, int fq) const {
        const int trow = u.pm * BM; const int batch = trow < NPROMPT ? (trow >> 11) : 8;
        const int row0 = trow + wr * 64 + fr, col0 = u.pn * BM + wc * 32 + 4 * fq;
        const float* mb = mod + (size_t)batch * MODW + col0;
        f32x4 gv[2][2], mv[2][2];
#pragma unroll
        for (int bj = 0; bj < 2; ++bj)
#pragma unroll
            for (int n = 0; n < 2; ++n) { gv[bj][n] = *(const f32x4*)(mb + 2 * DM + bj * HALF + n * 16);
                mv[bj][n] = *(const f32x4*)(gmlp + col0 + bj * HALF + n * 16) * (1.f + *(const f32x4*)(mb + 4 * DM + bj * HALF + n * 16)); }
        f32x4 xr[2][4];
#define WO_LOAD(buf, g) do { const int row_ = row0 + ((g) >> 2) * HALF + ((g) & 3) * 16; \
            const float* src_ = (row_ < NPROMPT ? xa + (size_t)row_ * DM : xb + (size_t)(row_ - NPROMPT) * DM) + col0; \
            _Pragma("unroll") for (int q_ = 0; q_ < 4; ++q_) xr[buf][q_] = *(const f32x4*)(src_ + (q_ >> 1) * HALF + (q_ & 1) * 16); } while (0)
        WO_LOAD(0, 0);
#pragma unroll
        for (int g = 0; g < 8; ++g) { const int ai = g >> 2, m = g & 3; const int row = row0 + ai * HALF + m * 16;
            if (g + 1 < 8) WO_LOAD((g + 1) & 1, g + 1);
            float* dst = out + (size_t)row * DM + col0; bf16_t* ud = U + (size_t)row * DM + col0; float sq = 0.f;
#pragma unroll
            for (int bj = 0; bj < 2; ++bj)
#pragma unroll
                for (int n = 0; n < 2; ++n) { const f32x4 v = xr[g & 1][bj * 2 + n] + gv[bj][n] * acc[ai][bj][m][n];
                    *(f32x4*)(dst + bj * HALF + n * 16) = v; sq += v[0] * v[0] + v[1] * v[1] + v[2] * v[2] + v[3] * v[3];
                    const f32x4 uu = v * mv[bj][n]; u32x2 w; w.x = cvt_pk_bf16(uu[0], uu[1]); w.y = cvt_pk_bf16(uu[2], uu[3]); *(u32x2*)(ud + bj * HALF + n * 16) = w; }
            sq += __shfl_xor(sq, 16); sq += __shfl_xor(sq, 32);
            if (fq == 0) (void)__hip_atomic_fetch_add(ss2 + row, sq, __ATOMIC_RELAXED, __HIP_MEMORY_SCOPE_AGENT); }
#undef WO_LOAD
    }
};
struct EpiFfn1 {
    static constexpr bool PERM = true, AFTER_DRAIN = false;
    bf16_t* O; const float* ss2; const float* bias2; int row_off;
    __device__ __forceinline__ void operator()(const f32x4 (&acc)[2][2][4][2], const Unit& u, int wr, int wc, int fr, int fq) const {
        const int trow = row_off + u.pm * BM; const int batch = trow < NPROMPT ? (trow >> 11) : 8;
        const int row0 = u.pm * BM + wr * 64 + fr; const int col0 = u.pn * BM + wc * 32 + 8 * fq;
        const float* bp = bias2 + (size_t)batch * DFF + col0;
        f32x4 bv[2][2];
#pragma unroll
        for (int bj = 0; bj < 2; ++bj)
#pragma unroll
            for (int n = 0; n < 2; ++n) bv[bj][n] = *(const f32x4*)(bp + bj * HALF + 4 * n);
        float ssv[2][4];
#pragma unroll
        for (int ai = 0; ai < 2; ++ai)
#pragma unroll
            for (int m = 0; m < 4; ++m) ssv[ai][m] = ss2[row_off + row0 + ai * HALF + m * 16];
#pragma unroll
        for (int ai = 0; ai < 2; ++ai)
#pragma unroll
            for (int m = 0; m < 4; ++m) asm volatile("" : "+v"(ssv[ai][m]));
#pragma unroll
        for (int ai = 0; ai < 2; ++ai)
#pragma unroll
            for (int m = 0; m < 4; ++m) { const int lrow = row0 + ai * HALF + m * 16; bf16_t* rowp = O + (size_t)lrow * DFF + col0;
                const float rs = rsqrtf(ssv[ai][m] * (1.f / DM) + EPS);
#pragma unroll
                for (int bj = 0; bj < 2; ++bj) { f32x4 v0 = acc[ai][bj][m][0] * rs + bv[bj][0], v1 = acc[ai][bj][m][1] * rs + bv[bj][1];
#pragma unroll
                    for (int j = 0; j < 4; ++j) { const float a = fmaxf(v0[j], 0.f), b = fmaxf(v1[j], 0.f); v0[j] = a * a; v1[j] = b * b; }
                    u32x4 w; w.x = cvt_pk_bf16(v0[0], v0[1]); w.y = cvt_pk_bf16(v0[2], v0[3]); w.z = cvt_pk_bf16(v1[0], v1[1]); w.w = cvt_pk_bf16(v1[2], v1[3]);
                    *(u32x4*)(rowp + bj * HALF) = w; } }
    }
};
struct EpiFinal {
    static constexpr bool PERM = false, AFTER_DRAIN = true;
    float* out; const float* gate; const float* gfinal; float* sspart; int row_off; XcdBarrier bar;
    __device__ __forceinline__ void fused(f32x4 (&acc)[2][2][4][2], const Unit& u, int wr, int wc, int fr, int fq, LAS unsigned char* lds) const {
        LAS float* P = (LAS float*)lds;
        LAS float* S = (LAS float*)(lds + 4096);
        const int trow = row_off + u.pm * BM; const int batch = trow < NPROMPT ? (trow >> 11) : 8;
        const int row0 = trow + wr * 64 + fr, col0 = u.pn * BM + wc * 32 + 4 * fq;
        {
            const float* gp = gate + (size_t)batch * MODW + col0;
            f32x4 gv[2][2];
#pragma unroll
            for (int bj = 0; bj < 2; ++bj)
#pragma unroll
                for (int n = 0; n < 2; ++n) gv[bj][n] = *(const f32x4*)(gp + bj * HALF + n * 16);
            f32x4 xr[3][4];
#define FN_LOAD(buf, g) do { const float* src_ = out + (size_t)(row0 + ((g) >> 2) * HALF + ((g) & 3) * 16) * DM + col0; \
                _Pragma("unroll") for (int q_ = 0; q_ < 4; ++q_) xr[buf][q_] = *(const f32x4*)(src_ + (q_ >> 1) * HALF + (q_ & 1) * 16); } while (0)
            FN_LOAD(0, 0); FN_LOAD(1, 1);
#pragma unroll
            for (int g = 0; g < 8; ++g) { const int ai = g >> 2, m = g & 3; float sq = 0.f;
                if (g + 2 < 8) FN_LOAD((g + 2) % 3, g + 2);
#pragma unroll
                for (int bj = 0; bj < 2; ++bj)
#pragma unroll
                    for (int n = 0; n < 2; ++n) { const f32x4 v = xr[g % 3][bj * 2 + n] + gv[bj][n] * acc[ai][bj][m][n]; acc[ai][bj][m][n] = v;
                        sq += v[0] * v[0] + v[1] * v[1] + v[2] * v[2] + v[3] * v[3]; }
                sq += __shfl_xor(sq, 16); sq += __shfl_xor(sq, 32);
                if (fq == 0) P[(ai * HALF + wr * 64 + m * 16 + fr) * 4 + wc] = sq; }
#undef FN_LOAD
        }
        __syncthreads();
        if (threadIdx.x < 256) { const int r = threadIdx.x; sspart[(size_t)(trow + r) * 8 + u.pn] = (P[r * 4] + P[r * 4 + 1]) + (P[r * 4 + 2] + P[r * 4 + 3]); }
        xcd_barrier(bar);
        if (threadIdx.x < 256) { const int r = threadIdx.x; const f32x4 a = *(const f32x4*)(sspart + (size_t)(trow + r) * 8), b = *(const f32x4*)(sspart + (size_t)(trow + r) * 8 + 4);
            const float tot = ((a[0] + a[1]) + (a[2] + a[3])) + ((b[0] + b[1]) + (b[2] + b[3])); S[r] = rsqrtf(tot * (1.f / DM) + EPS); }
        __syncthreads();
        f32x4 gf[2][2];
#pragma unroll
        for (int bj = 0; bj < 2; ++bj)
#pragma unroll
            for (int n = 0; n < 2; ++n) gf[bj][n] = *(const f32x4*)(gfinal + col0 + bj * HALF + n * 16);
#pragma unroll
        for (int ai = 0; ai < 2; ++ai)
#pragma unroll
            for (int m = 0; m < 4; ++m) { const int r = ai * HALF + wr * 64 + m * 16 + fr; const float rs = S[r]; float* dst = out + (size_t)(trow + r) * DM + col0;
#pragma unroll
                for (int bj = 0; bj < 2; ++bj)
#pragma unroll
                    for (int n = 0; n < 2; ++n) *(f32x4*)(dst + bj * HALF + n * 16) = acc[ai][bj][m][n] * rs * gf[bj][n]; }
    }
};

template <class Epi>
__device__ __forceinline__ void gemm_phase(LAS unsigned char* lds, const Gemm g, const StaticOrder& S, const Epi& E) {
    int tid_ = threadIdx.x; asm volatile("" : "+v"(tid_));
    const int tid = tid_, wid = __builtin_amdgcn_readfirstlane(tid >> 6), lane = tid & 63, wr = wid >> 2, wc = wid & 3, fr = lane & 15, fq = lane >> 4;
    const int K = g.K, nt = K / BK, lda = g.lda;
    unsigned voffA[2], voffB[2];
#pragma unroll
    for (int i = 0; i < 2; ++i) { int R, C; stage_rc(tid * 16 + i * 8192, R, C); const int Rb = Epi::PERM ? ((R & ~31) + perm32(R & 31)) : R;
        voffA[i] = (unsigned)(R * lda + C) * 2u; voffB[i] = (unsigned)(Rb * K + C) * 2u; }
    const size_t kstep = (size_t)(BK * 2);
    const size_t hstepA = (size_t)HALF * lda * 2, hstepB = (size_t)HALF * K * 2;
    const size_t tstepA = 2 * hstepA, tstepB = 2 * hstepB;
    const unsigned ldsw = (unsigned)wid * 1024u;
    const int aoff = lds_byte(wr * 64 + fr, fq * 8), boff = lds_byte(wc * 32 + fr, fq * 8);
#define PG8_SA(b, h) (((b) * 2 + (h)) * HTB)
#define PG8_SB(b, h) ((4 + (b) * 2 + (h)) * HTB)
#define PG8_STAGE(bufoff, gbase, voff) do { _Pragma("unroll") for (int _i = 0; _i < 2; ++_i) \
        __builtin_amdgcn_global_load_lds((const unsigned*)((const char*)(gbase) + (voff)[_i]), (LAS unsigned*)(lds + (bufoff) + ldsw + _i * 8192), 16, 0, 0); } while (0)
#define PG8_LDA(dst, b, h) do { _Pragma("unroll") for (int m = 0; m < 4; ++m) _Pragma("unroll") for (int k = 0; k < 2; ++k) dst[m][k] = *(const LAS bf16x8*)(lds + PG8_SA(b, h) + aoff + m * 2048 + k * 1024); } while (0)
#define PG8_LDB(dst, b, h) do { _Pragma("unroll") for (int n = 0; n < 2; ++n) _Pragma("unroll") for (int k = 0; k < 2; ++k) dst[n][k] = *(const LAS bf16x8*)(lds + PG8_SB(b, h) + boff + n * 2048 + k * 1024); } while (0)
#define PG8_MMA(ai, bj, At, Bt) do { __builtin_amdgcn_s_setprio(1); _Pragma("unroll") for (int m = 0; m < 4; ++m) _Pragma("unroll") for (int n = 0; n < 2; ++n) _Pragma("unroll") for (int k = 0; k < 2; ++k) \
        acc[ai][bj][m][n] = __builtin_amdgcn_mfma_f32_16x16x32_bf16(Bt[n][k], At[m][k], acc[ai][bj][m][n], 0, 0, 0); __builtin_amdgcn_s_setprio(0); } while (0)
#define PG8_WAIT_V(n) asm volatile("s_waitcnt vmcnt(" #n ")" ::: "memory")
#define PG8_WAIT_L(n) asm volatile("s_waitcnt lgkmcnt(" #n ")" ::: "memory")
#define PG8_BAR __builtin_amdgcn_s_barrier()
#define PG8_SCHED __builtin_amdgcn_sched_barrier(0)
    Unit cur, nxt; int ui = 0;
    if (!S.next(0, cur)) return;
    f32x4 acc[2][2][4][2];
#pragma unroll
    for (int a = 0; a < 2; ++a)
#pragma unroll
        for (int b = 0; b < 2; ++b)
#pragma unroll
            for (int m = 0; m < 4; ++m)
#pragma unroll
                for (int n = 0; n < 2; ++n) acc[a][b][m][n] = (f32x4){0.f, 0.f, 0.f, 0.f};
    bf16x8 At[4][2], B0[2][2], B1[2][2];
    const char* cA = (const char*)g.A + (size_t)cur.pm * tstepA; const char* cB = (const char*)g.Bt + (size_t)cur.pn * tstepB;
    PG8_STAGE(PG8_SB(0, 0), cB, voffB); PG8_STAGE(PG8_SA(0, 0), cA, voffA); PG8_STAGE(PG8_SB(0, 1), cB + hstepB, voffB); PG8_STAGE(PG8_SA(0, 1), cA + hstepA, voffA);
    if (wr == 1) PG8_BAR;
    PG8_WAIT_V(4); PG8_BAR;
    PG8_STAGE(PG8_SB(1, 0), cB + kstep, voffB); PG8_STAGE(PG8_SA(1, 0), cA + kstep, voffA); PG8_STAGE(PG8_SB(1, 1), cB + hstepB + kstep, voffB);
    PG8_WAIT_V(6); PG8_BAR;
    for (;;) {
        const bool has_next = S.next(ui + 1, nxt);
        const char* nA = has_next ? (const char*)g.A + (size_t)nxt.pm * tstepA : cA; const char* nB = has_next ? (const char*)g.Bt + (size_t)nxt.pn * tstepB : cB;
        for (int t = 0; t < nt; t += 2) {
            const bool last = (t == nt - 2);
            const char* a1 = cA + (size_t)(t + 1) * kstep;
            const char* a2 = last ? nA : cA + (size_t)(t + 2) * kstep; const char* b2 = last ? nB : cB + (size_t)(t + 2) * kstep;
            const char* a3 = a2 + kstep; const char* b3 = b2 + kstep;
            PG8_LDB(B0, 0, 0); PG8_SCHED; PG8_LDA(At, 0, 0); PG8_STAGE(PG8_SA(1, 1), a1 + hstepA, voffA);
            PG8_WAIT_L(8); PG8_BAR; PG8_WAIT_L(0); PG8_MMA(0, 0, At, B0); PG8_BAR; PG8_SCHED;
            PG8_LDB(B1, 0, 1); PG8_STAGE(PG8_SB(0, 0), b2, voffB);
            PG8_BAR; PG8_WAIT_L(0); PG8_MMA(0, 1, At, B1); PG8_BAR;
            PG8_LDA(At, 0, 1); PG8_STAGE(PG8_SA(0, 0), a2, voffA);
            PG8_BAR; PG8_WAIT_L(0); PG8_MMA(1, 0, At, B0); PG8_BAR; PG8_SCHED;
            PG8_STAGE(PG8_SB(0, 1), b2 + hstepB, voffB);
            PG8_WAIT_V(6); PG8_BAR; PG8_MMA(1, 1, At, B1); PG8_BAR;
            PG8_LDB(B0, 1, 0); PG8_SCHED; PG8_LDA(At, 1, 0); PG8_STAGE(PG8_SA(0, 1), a2 + hstepA, voffA);
            PG8_WAIT_L(8); PG8_BAR; PG8_WAIT_L(0); PG8_MMA(0, 0, At, B0); PG8_BAR; PG8_SCHED;
            PG8_LDB(B1, 1, 1); PG8_STAGE(PG8_SB(1, 0), b3, voffB);
            PG8_BAR; PG8_WAIT_L(0); PG8_MMA(0, 1, At, B1); PG8_BAR;
            PG8_LDA(At, 1, 1); PG8_STAGE(PG8_SA(1, 0), a3, voffA);
            PG8_BAR; PG8_WAIT_L(0); PG8_MMA(1, 0, At, B0); PG8_BAR; PG8_SCHED;
            PG8_STAGE(PG8_SB(1, 1), b3 + hstepB, voffB);
            PG8_WAIT_V(6); PG8_BAR; PG8_MMA(1, 1, At, B1); PG8_BAR;
        }
        if constexpr (!Epi::AFTER_DRAIN) E(acc, cur, wr, wc, fr, fq);
        if (!has_next) break;
#pragma unroll
        for (int a = 0; a < 2; ++a)
#pragma unroll
            for (int b = 0; b < 2; ++b)
#pragma unroll
                for (int m = 0; m < 4; ++m)
#pragma unroll
                    for (int n = 0; n < 2; ++n) acc[a][b][m][n] = (f32x4){0.f, 0.f, 0.f, 0.f};
        cur = nxt; cA = nA; cB = nB; ++ui;
    }
    PG8_WAIT_V(0);
    if (wr == 0) PG8_BAR;
    PG8_BAR;
    if constexpr (Epi::AFTER_DRAIN) E.fused(acc, cur, wr, wc, fr, fq, lds);
#undef PG8_SA
#undef PG8_SB
#undef PG8_STAGE
#undef PG8_LDA
#undef PG8_LDB
#undef PG8_MMA
#undef PG8_WAIT_V
#undef PG8_WAIT_L
#undef PG8_BAR
#undef PG8_SCHED
}
}


#ifndef ATT_SDEPTH
#define ATT_SDEPTH 2
#endif
namespace att {
constexpr int SHM_V = 16384, SHM_K = 16384, SHM_KR = 8192;
constexpr int OFF_V = 0, OFF_K = 49152, OFF_KR = 81920, OFF_WS = 98304, OFF_BL = 100352, OFF_QR = 103424, ATT_LDS_END = 136192;
constexpr float SCALE_A = 0.088388347648318440f;
constexpr float SCALE_B = 0.072168783648703220f;
constexpr float THR = 8.f;
#define KSWZ(row, colB) ((row) * 256 + ((colB) ^ (((row) & 15) << 4)))
#define KRSWZ(row, colB) ((row) * 128 + ((colB) ^ ((((row) >> 1) & 7) << 4)))
#define SBAR() __builtin_amdgcn_sched_barrier(0)
__device__ __forceinline__ int crow(int r, int hi) { return (r & 3) + 8 * (r >> 2) + 4 * hi; }
__device__ __forceinline__ bf16x8 ld8(const bf16_t* p) { return *reinterpret_cast<const bf16x8*>(p); }

template <int MODE>
__device__ __forceinline__ void partialSM(f32x16& p0, f32x16& p1, float& m_reg, float& mn, float& alpha, const float* bl, int idx0) {
    if constexpr (MODE == 1) {
        constexpr float C = SCALE_B * LOG2E;
        float pmax = p0[0];
#pragma unroll
        for (int r = 1; r < 16; ++r) pmax = fmaxf(pmax, p0[r]);
#pragma unroll
        for (int r = 0; r < 16; ++r) pmax = fmaxf(pmax, p1[r]);
        { auto rr = __builtin_amdgcn_permlane32_swap(__float_as_uint(pmax), __float_as_uint(pmax), false, false);
          pmax = fmaxf(__uint_as_float(rr[0]), __uint_as_float(rr[1])); }
        if (__builtin_expect(__all(pmax - m_reg <= THR / SCALE_B), 1)) { mn = m_reg; alpha = 1.f; }
        else { mn = fmaxf(m_reg, pmax); alpha = __builtin_amdgcn_exp2f((m_reg - mn) * C); m_reg = mn; }
        const float mnC = -mn * C;
#pragma unroll
        for (int r = 0; r < 16; ++r) p0[r] = fmaf(p0[r], C, mnC);
#pragma unroll
        for (int r = 0; r < 16; ++r) p1[r] = fmaf(p1[r], C, mnC);
#pragma unroll
        for (int r = 0; r < 16; ++r) p0[r] = __builtin_amdgcn_exp2f(p0[r]);
    } else {
        constexpr float C = SCALE_A * LOG2E;
#pragma unroll
        for (int r4 = 0; r4 < 4; ++r4) {
#pragma unroll
            for (int e = 0; e < 4; ++e) { const int r = r4 * 4 + e, off = e + 8 * r4; p0[r] = fmaf(p0[r], C, bl[idx0 + off]); p1[r] = fmaf(p1[r], C, bl[idx0 + 32 + off]); }
            asm volatile("" ::: "memory");
        }
        float pmax = p0[0];
#pragma unroll
        for (int r = 1; r < 16; ++r) pmax = fmaxf(pmax, p0[r]);
#pragma unroll
        for (int r = 0; r < 16; ++r) pmax = fmaxf(pmax, p1[r]);
        { auto rr = __builtin_amdgcn_permlane32_swap(__float_as_uint(pmax), __float_as_uint(pmax), false, false);
          pmax = fmaxf(__uint_as_float(rr[0]), __uint_as_float(rr[1])); }
        if (__builtin_expect(__all(pmax - m_reg <= THR * LOG2E), 1)) { mn = m_reg; alpha = 1.f; }
        else { mn = fmaxf(m_reg, pmax); alpha = __builtin_amdgcn_exp2f(m_reg - mn); m_reg = mn; }
#pragma unroll
        for (int r = 0; r < 16; ++r) p0[r] = __builtin_amdgcn_exp2f(p0[r] - mn);
#pragma unroll
        for (int r = 0; r < 16; ++r) p1[r] = p1[r] - mn;
    }
}
__device__ __forceinline__ void finishSM(f32x16& p0, f32x16& p1, float alpha, float& l_reg, bf16x8& pa0, bf16x8& pa1, bf16x8& pa2, bf16x8& pa3) {
#pragma unroll
    for (int r = 0; r < 16; ++r) p1[r] = __builtin_amdgcn_exp2f(p1[r]);
    float ps = 0;
#pragma unroll
    for (int r = 0; r < 16; ++r) ps += p0[r];
#pragma unroll
    for (int r = 0; r < 16; ++r) ps += p1[r];
    { auto rr = __builtin_amdgcn_permlane32_swap(__float_as_uint(ps), __float_as_uint(ps), false, false);
      ps = __uint_as_float(rr[0]) + __uint_as_float(rr[1]); }
    l_reg = l_reg * alpha + ps;
#define PK4(P, BASE, OUT) do { unsigned a0 = cvt_pk_bf16(P[BASE + 0], P[BASE + 1]), a1 = cvt_pk_bf16(P[BASE + 2], P[BASE + 3]);   \
    unsigned b0 = cvt_pk_bf16(P[BASE + 4], P[BASE + 5]), b1 = cvt_pk_bf16(P[BASE + 6], P[BASE + 7]);                              \
    auto r0 = __builtin_amdgcn_permlane32_swap(a0, b0, false, false); auto r1 = __builtin_amdgcn_permlane32_swap(a1, b1, false, false); \
    u32x4 w = {r0[0], r1[0], r0[1], r1[1]}; OUT = *reinterpret_cast<bf16x8*>(&w); } while (0)
    PK4(p0, 0, pa0); PK4(p0, 8, pa1); PK4(p1, 0, pa2); PK4(p1, 8, pa3);
#undef PK4
}
__device__ __forceinline__ void finishSM_unused_nv(f32x16& p0, f32x16& p1, float alpha, float& l_reg, bf16x8& pa0, bf16x8& pa1, bf16x8& pa2, bf16x8& pa3) {
#pragma unroll
    for (int r = 0; r < 16; ++r) p1[r] = __builtin_amdgcn_exp2f(p1[r]);
    float ps = 0;
#pragma unroll
    for (int r = 0; r < 16; ++r) ps += p0[r];
#pragma unroll
    for (int r = 0; r < 16; ++r) ps += p1[r];
    { auto rr = __builtin_amdgcn_permlane32_swap(__float_as_uint(ps), __float_as_uint(ps), false, false);
      ps = __uint_as_float(rr[0]) + __uint_as_float(rr[1]); }
    l_reg = l_reg * alpha + ps;
#define PK4N(P, BASE, OUT) do { unsigned a0 = cvt_pk_nv(P[BASE + 0], P[BASE + 1]), a1 = cvt_pk_nv(P[BASE + 2], P[BASE + 3]);   \
    unsigned b0 = cvt_pk_nv(P[BASE + 4], P[BASE + 5]), b1 = cvt_pk_nv(P[BASE + 6], P[BASE + 7]);                              \
    auto r0 = __builtin_amdgcn_permlane32_swap(a0, b0, false, false); auto r1 = __builtin_amdgcn_permlane32_swap(a1, b1, false, false); \
    u32x4 w = {r0[0], r1[0], r0[1], r1[1]}; OUT = *reinterpret_cast<bf16x8*>(&w); } while (0)
    PK4N(p0, 0, pa0); PK4N(p0, 8, pa1); PK4N(p1, 0, pa2); PK4N(p1, 8, pa3);
#undef PK4N
}
template <int MODE>
__device__ __forceinline__ void qkt(f32x16& p0, f32x16& p1, const char* Ks, const char* Krs, const bf16x8* qr, const char* QRw, int qsw, int r32, int hi) {
    p0 = f32x16{}; p1 = f32x16{};
#pragma unroll
    for (int d0 = 0; d0 < 8; ++d0) { const int cb = (d0 * 16 + hi * 8) * 2;
        bf16x8 b0 = *reinterpret_cast<const bf16x8*>(Ks + KSWZ(r32, cb));
        bf16x8 b1 = *reinterpret_cast<const bf16x8*>(Ks + KSWZ(32 + r32, cb));
        p0 = __builtin_amdgcn_mfma_f32_32x32x16_bf16(b0, qr[d0], p0, 0, 0, 0);
        p1 = __builtin_amdgcn_mfma_f32_32x32x16_bf16(b1, qr[d0], p1, 0, 0, 0); }
    if constexpr (MODE == 1) {
#pragma unroll
        for (int d0 = 0; d0 < 4; ++d0) { const int cb = (d0 * 16 + hi * 8) * 2;
            bf16x8 b0 = *reinterpret_cast<const bf16x8*>(Krs + KRSWZ(r32, cb));
            bf16x8 b1 = *reinterpret_cast<const bf16x8*>(Krs + KRSWZ(32 + r32, cb));
            p0 = __builtin_amdgcn_mfma_f32_32x32x16_bf16(b0, qr[8 + d0], p0, 0, 0, 0);
            p1 = __builtin_amdgcn_mfma_f32_32x32x16_bf16(b1, qr[8 + d0], p1, 0, 0, 0); }
    }
}
__device__ __forceinline__ int v_st(int k, int c) { const int kk = (k & ~0xC) | ((k & 4) << 1) | ((k & 8) >> 1); return ((kk >> 3) * 4 + (c >> 5)) * 512 + ((kk & 7) * 32 + (c & 31)) * 2; }
__device__ __forceinline__ int v_rd_base(int lane) { return ((lane & 3) << 3) | (((lane >> 2) & 3) << 6) | (((lane >> 4) & 1) << 5) | (((lane >> 5) & 1) << 8); }
constexpr int v_rd_off(int d0, int ks, int half) { return d0 * 512 + ks * 4096 + half * 2048; }
template <int OFF> __device__ __forceinline__ s16x4 tr_read(int vb) {
    s16x4 r; asm volatile("ds_read_b64_tr_b16 %0, %1 offset:%2" : "=&v"(r) : "v"(vb), "i"(OFF) : "memory"); return r;
}
template <int D0> __device__ __forceinline__ void pv_one(f32x16& od, int vb, bf16x8 pa0, bf16x8 pa1, bf16x8 pa2, bf16x8 pa3) {
    const s16x4 l0 = tr_read<v_rd_off(D0, 0, 0)>(vb), h0 = tr_read<v_rd_off(D0, 0, 1)>(vb), l1 = tr_read<v_rd_off(D0, 1, 0)>(vb), h1 = tr_read<v_rd_off(D0, 1, 1)>(vb);
    const s16x4 l2 = tr_read<v_rd_off(D0, 2, 0)>(vb), h2 = tr_read<v_rd_off(D0, 2, 1)>(vb), l3 = tr_read<v_rd_off(D0, 3, 0)>(vb), h3 = tr_read<v_rd_off(D0, 3, 1)>(vb);
    asm volatile("s_waitcnt lgkmcnt(0)" ::: "memory"); SBAR();
#define PK(L, H) (bf16x8){L[0], L[1], L[2], L[3], H[0], H[1], H[2], H[3]}
    od = __builtin_amdgcn_mfma_f32_32x32x16_bf16(pa0, PK(l0, h0), od, 0, 0, 0);
    od = __builtin_amdgcn_mfma_f32_32x32x16_bf16(pa1, PK(l1, h1), od, 0, 0, 0);
    od = __builtin_amdgcn_mfma_f32_32x32x16_bf16(pa2, PK(l2, h2), od, 0, 0, 0);
    od = __builtin_amdgcn_mfma_f32_32x32x16_bf16(pa3, PK(l3, h3), od, 0, 0, 0);
#undef PK
}
__device__ __forceinline__ void pv_d0(f32x16* o, int vb, bf16x8 pa0, bf16x8 pa1, bf16x8 pa2, bf16x8 pa3) {
    pv_one<0>(o[0], vb, pa0, pa1, pa2, pa3); pv_one<1>(o[1], vb, pa0, pa1, pa2, pa3); pv_one<2>(o[2], vb, pa0, pa1, pa2, pa3); pv_one<3>(o[3], vb, pa0, pa1, pa2, pa3);
}

template <int MODE>
__device__ __forceinline__ void qk_half(f32x16& p, const char* Ks, const char* Krs, int rowoff, const bf16x8* qr, const char* QRw, int qsw, int r32, int hi) {
    p = f32x16{};
#pragma unroll
    for (int d0 = 0; d0 < 8; ++d0) { const int cb = (d0 * 16 + hi * 8) * 2;
        const bf16x8 b = *reinterpret_cast<const bf16x8*>(Ks + KSWZ(rowoff + r32, cb));
        p = __builtin_amdgcn_mfma_f32_32x32x16_bf16(b, qr[d0], p, 0, 0, 0); }
    if constexpr (MODE == 1) {
#pragma unroll
        for (int d0 = 0; d0 < 4; ++d0) { const int cb = (d0 * 16 + hi * 8) * 2;
            const bf16x8 b = *reinterpret_cast<const bf16x8*>(Krs + KRSWZ(rowoff + r32, cb));
            p = __builtin_amdgcn_mfma_f32_32x32x16_bf16(b, qr[8 + d0], p, 0, 0, 0); }
#ifdef XTRA_MFMA
        bf16x8 qz = {0, 0, 0, 0, 0, 0, 0, 0}; asm volatile("" : "+v"(qz));
#pragma unroll
        for (int e = 0; e < XTRA_MFMA; ++e) p = __builtin_amdgcn_mfma_f32_32x32x16_bf16(qr[e & 7], qz, p, 0, 0, 0);
#endif
    }
}
template <int MODE>
__device__ __forceinline__ void half_max(f32x16& p, float& m_reg, float& mn, float& alpha, const float* bl, int idx) {
    if constexpr (MODE == 0) {
        constexpr float C = SCALE_A * LOG2E;
#pragma unroll
        for (int r4 = 0; r4 < 4; ++r4) {
#pragma unroll
            for (int e = 0; e < 4; ++e) { const int r = r4 * 4 + e, off = e + 8 * r4; p[r] = fmaf(p[r], C, bl[idx + off]); }
        }
    }
    float pmax = fmaxf(p[0], p[1]);
#pragma unroll
    for (int r = 2; r < 16; ++r) pmax = fmaxf(pmax, p[r]);
    { auto rr = __builtin_amdgcn_permlane32_swap(__float_as_uint(pmax), __float_as_uint(pmax), false, false);
      pmax = fmaxf(__uint_as_float(rr[0]), __uint_as_float(rr[1])); }
    if constexpr (MODE == 1) {
        constexpr float C = SCALE_B * LOG2E;
        if (__builtin_expect(__all(pmax - m_reg <= THR / SCALE_B), 1)) { mn = m_reg; alpha = 1.f; }
        else { mn = fmaxf(m_reg, pmax); alpha = __builtin_amdgcn_exp2f((m_reg - mn) * C); m_reg = mn; }
    } else {
        if (__builtin_expect(__all(pmax - m_reg <= THR * LOG2E), 1)) { mn = m_reg; alpha = 1.f; }
        else { mn = fmaxf(m_reg, pmax); alpha = __builtin_amdgcn_exp2f(m_reg - mn); m_reg = mn; }
    }
}
template <int MODE>
__device__ __forceinline__ void half_exp(f32x16& p, float mn, float alpha, float& l_reg, bf16x8& paA, bf16x8& paB) {
    if constexpr (MODE == 1) {
        constexpr float C = SCALE_B * LOG2E; const float mnC = -mn * C;
#pragma unroll
        for (int r = 0; r < 16; ++r) p[r] = __builtin_amdgcn_exp2f(fmaf(p[r], C, mnC));
    } else {
#pragma unroll
        for (int r = 0; r < 16; ++r) p[r] = __builtin_amdgcn_exp2f(p[r] - mn);
    }
    float ps = 0;
#pragma unroll
    for (int r = 0; r < 16; ++r) ps += p[r];
    { auto rr = __builtin_amdgcn_permlane32_swap(__float_as_uint(ps), __float_as_uint(ps), false, false);
      ps = __uint_as_float(rr[0]) + __uint_as_float(rr[1]); }
    l_reg = l_reg * alpha + ps;
#define PK4N(P, BASE, OUT) do { unsigned a0 = cvt_pk_nv(P[BASE + 0], P[BASE + 1]), a1 = cvt_pk_nv(P[BASE + 2], P[BASE + 3]);   \
    unsigned b0 = cvt_pk_nv(P[BASE + 4], P[BASE + 5]), b1 = cvt_pk_nv(P[BASE + 6], P[BASE + 7]);                              \
    auto r0 = __builtin_amdgcn_permlane32_swap(a0, b0, false, false); auto r1 = __builtin_amdgcn_permlane32_swap(a1, b1, false, false); \
    u32x4 w = {r0[0], r1[0], r0[1], r1[1]}; OUT = *reinterpret_cast<bf16x8*>(&w); } while (0)
    PK4N(p, 0, paA); PK4N(p, 8, paB);
#undef PK4N
}
template <int H>
__device__ __forceinline__ void pv_half(f32x16* o, unsigned vl, bf16x8 paA, bf16x8 paB) {
    typedef LAS s16x4* trp;
#define TRR(d0, ks, half) __builtin_amdgcn_ds_read_tr16_b64_v4i16((trp)(vl + (unsigned)v_rd_off(d0, ks, half)))
#define PKV(L, Hh) (bf16x8){L[0], L[1], L[2], L[3], Hh[0], Hh[1], Hh[2], Hh[3]}
#pragma unroll
    for (int d0 = 0; d0 < 4; ++d0) {
        const s16x4 lA = TRR(d0, 2 * H, 0), hA = TRR(d0, 2 * H, 1), lB = TRR(d0, 2 * H + 1, 0), hB = TRR(d0, 2 * H + 1, 1);
        o[d0] = __builtin_amdgcn_mfma_f32_32x32x16_bf16(paA, PKV(lA, hA), o[d0], 0, 0, 0);
        o[d0] = __builtin_amdgcn_mfma_f32_32x32x16_bf16(paB, PKV(lB, hB), o[d0], 0, 0, 0);
    }
#undef TRR
#undef PKV
}

template <int MODE>
__device__ __forceinline__ void attn_item(const bf16_t* __restrict__ Qb, const bf16_t* __restrict__ Qrb, const bf16_t* __restrict__ Kh, const bf16_t* __restrict__ Krh,
                                          const bf16_t* __restrict__ Vh, bf16_t* __restrict__ Ob, int NT, int relbase, float m_init, float l_init, char* lds) {
    constexpr int LDK = MODE ? 2048 : LDP;
    constexpr int SDEPTH = 1;
    int tid_ = threadIdx.x; asm volatile("" : "+v"(tid_));
    const int tid = tid_, wid = tid >> 6, lane = tid & 63, r32 = lane & 31, hi = lane >> 5;
    char* V_lds = lds + OFF_V; char* K_lds = lds + OFF_K; char* KR_lds = lds + OFF_KR;
    float* ws = (float*)(lds + OFF_WS) + wid * 64; float* li_l = ws; float* al_l = ws + 32;
    const float* bl = (const float*)(lds + OFF_BL);
    float m_reg = m_init, l_reg = l_init; f32x16 o[4] = {}; bf16x8 qr[MODE ? 12 : 8];
    const bf16_t* Qw = Qb + (long)(wid * 32 + r32) * LDP + hi * 8;
#pragma unroll
    for (int d0 = 0; d0 < 8; ++d0) qr[d0] = ld8(Qw + d0 * 16);
    char* QR_lds = lds + OFF_QR; const int qrow = wid * 32 + r32;
    const char* QRw = QR_lds + qrow * 128; const int qsw = ((qrow >> 1) & 7) << 4;
    if constexpr (MODE == 1) {
        const bf16_t* Qrw = Qrb + (long)(wid * 32 + r32) * LDP + hi * 8;
#pragma unroll
        for (int d0 = 0; d0 < 4; ++d0) qr[8 + d0] = ld8(Qrw + d0 * 16);
    }
    const int widu = __builtin_amdgcn_readfirstlane(tid >> 6);
    LAS unsigned char* l3 = (LAS unsigned char*)lds;
    const unsigned wbase = (unsigned)widu * 1024u;
    int offK, offV, offKR;
    { const int row = tid >> 4, cpos = tid & 15; offK = row * LDK + ((cpos ^ (row & 15)) * 8); }
    { const int kkhi = tid >> 7, chi = (tid >> 5) & 3, w = tid & 31, kk = kkhi * 8 + (w >> 2), k = (kk & ~0xC) | ((kk & 4) << 1) | ((kk & 8) >> 1); offV = k * LDK + chi * 32 + (w & 3) * 8; }
    { const int row = tid >> 3, cpos = tid & 7; offKR = row * LDP + ((cpos ^ ((row >> 1) & 7)) * 8); }
    const int vb0 = (int)(uintptr_t)V_lds + v_rd_base(lane);
    const int idxw = relbase - wid * 32 - r32 + 384 + 4 * hi;
#define GLDS(gptr, ldsoff) __builtin_amdgcn_global_load_lds((const unsigned*)(gptr), (LAS unsigned*)(l3 + (ldsoff)), 16, 0, 0)
#define TLOAD(kb, vb_, k0) do { const bf16_t* kg_ = Kh + (long)(k0) * LDK + offK; const bf16_t* vg_ = Vh + (long)(k0) * LDK + offV; \
    GLDS(kg_, OFF_K + (kb) * SHM_K + wbase); GLDS(kg_ + 32 * LDK, OFF_K + (kb) * SHM_K + wbase + 8192u); \
    GLDS(vg_, OFF_V + (vb_) * SHM_V + wbase); GLDS(vg_ + 32 * LDK, OFF_V + (vb_) * SHM_V + wbase + 8192u); \
    if constexpr (MODE == 1) GLDS(Krh + (long)(k0) * LDP + offKR, OFF_KR + (kb) * SHM_KR + wbase); } while (0)
#define RESC(a) do { if (__any((a) < 1.f)) { if (hi == 0) al_l[r32] = (a); asm volatile("s_waitcnt lgkmcnt(0)" ::: "memory"); \
    _Pragma("unroll") for (int d = 0; d < 4; ++d) _Pragma("unroll") for (int r = 0; r < 16; ++r) o[d][r] *= al_l[crow(r, hi)]; } } while (0)
    f32x16 pA0, pA1, pB0, pB1; float mnA, mnB, alA, alB; bf16x8 pa0, pa1, pa2, pa3;
    const unsigned vl0 = (unsigned)(uintptr_t)(l3 + OFF_V) + (unsigned)v_rd_base(lane);
#define QK2(P0, P1, kb) qkt<MODE>(P0, P1, K_lds + (kb) * SHM_K, KR_lds + (kb) * SHM_KR, qr, QRw, qsw, r32, hi)
#define PV2(vbuf) pv_d0(o, vb0 + (vbuf) * SHM_V, pa0, pa1, pa2, pa3)
#define TBAR() do { asm volatile("s_waitcnt vmcnt(0)" ::: "memory"); __syncthreads(); } while (0)
    int vprev = 0, vcur = 1, vnext = 2;
    TLOAD(0, 0, 0); asm volatile("s_waitcnt vmcnt(0)" ::: "memory"); __syncthreads();
    if (1 < NT) TLOAD(1, 1, 64);
    QK2(pA0, pA1, 0); partialSM<MODE>(pA0, pA1, m_reg, mnA, alA, bl, idxw);
    RESC(alA);
    TBAR();
    for (int j = 1; j + 1 < NT; j += 2) {
        if (j + 1 < NT) TLOAD(0, vnext, (j + 1) * 64);
        SBAR(); QK2(pB0, pB1, 1); finishSM(pA0, pA1, alA, l_reg, pa0, pa1, pa2, pa3); SBAR();
        PV2(vprev); partialSM<MODE>(pB0, pB1, m_reg, mnB, alB, bl, idxw + 64 * j);
        RESC(alB);
        TBAR();
        { const int t_ = vprev; vprev = vcur; vcur = vnext; vnext = t_; }
        if (j + 2 < NT) TLOAD(1, vnext, (j + 2) * 64);
        SBAR(); QK2(pA0, pA1, 0); finishSM(pB0, pB1, alB, l_reg, pa0, pa1, pa2, pa3); SBAR();
        PV2(vprev); partialSM<MODE>(pA0, pA1, m_reg, mnA, alA, bl, idxw + 64 * (j + 1));
        RESC(alA);
        TBAR();
        { const int t_ = vprev; vprev = vcur; vcur = vnext; vnext = t_; }
    }
    SBAR(); QK2(pB0, pB1, 1); finishSM(pA0, pA1, alA, l_reg, pa0, pa1, pa2, pa3); SBAR();
    PV2(vprev); partialSM<MODE>(pB0, pB1, m_reg, mnB, alB, bl, idxw + 64 * (NT - 1));
    RESC(alB);
    finishSM(pB0, pB1, alB, l_reg, pa0, pa1, pa2, pa3);
    PV2(vcur);
    __syncthreads();
#undef QK2
#undef PV2
#undef TBAR
    if (hi == 0) li_l[r32] = l_reg; asm volatile("s_waitcnt lgkmcnt(0)" ::: "memory");
    float rli[16];
#pragma unroll
    for (int r = 0; r < 16; ++r) rli[r] = __builtin_amdgcn_rcpf(li_l[crow(r, hi)]);
    __syncthreads();
    char* stg = lds + wid * 8704;
#pragma unroll
    for (int r = 0; r < 16; ++r) { const int orow = crow(r, hi);
#pragma unroll
        for (int d0 = 0; d0 < 4; ++d0) *(bf16_t*)(stg + orow * 272 + (d0 * 32 + r32) * 2) = f2bf(o[d0][r] * rli[r]); }
    asm volatile("s_waitcnt lgkmcnt(0)" ::: "memory");
    bf16_t* Ow = Ob + (long)(wid * 32 + (lane >> 4)) * LDP + (lane & 15) * 8;
    const char* srd = stg + (lane >> 4) * 272 + (lane & 15) * 16;
#pragma unroll
    for (int i = 0; i < 8; ++i) *(u32x4*)(Ow + (long)(i * 4) * LDP) = *(const u32x4*)(srd + i * 4 * 272);
#undef GLDS
#undef TLOAD
#undef RESC
}
}

__device__ __forceinline__ int win_dst_row(int n0) {
    if (n0 < 1024) return n0;
    if (n0 < 1536) return n0 + 1024;
    if (n0 < 2560) return n0 - 512;
    return n0;
}

__device__ __forceinline__ void phase0(const Params& p, unsigned char* lds_) {
    const int tid = threadIdx.x;
    bf16_t* wt_in = (bf16_t*)(p.ws + WS_WIN);
    for (int i = blockIdx.x * 512 + tid; i < 192 * DM * 2 / 16; i += gridDim.x * 512) ((u32x4*)(wt_in + (size_t)3648 * DM))[i] = (u32x4){0u, 0u, 0u, 0u};
    float* tile = (float*)lds_;
    constexpr int T_IN = 32 * 57, T_KVB = 8 * 32, T_O = 32 * 32, T_FF1 = 32 * 128, T_FF2 = 128 * 32, T_ALL = T_IN + T_KVB + T_O + T_FF1 + T_FF2;
    for (int t = blockIdx.x; t < T_ALL; t += gridDim.x) {
        const float* src; bf16_t* dst; int K, N, tt = t; bool isin = false;
        if (tt < T_IN) { src = p.w_in; dst = wt_in; K = 2048; N = 3648; isin = true; }
        else if ((tt -= T_IN) < T_KVB) { src = p.w_kv_b; dst = (bf16_t*)(p.ws + WS_WKVB); K = 512; N = 2048; }
        else if ((tt -= T_KVB) < T_O) { src = p.w_o; dst = (bf16_t*)(p.ws + WS_WO); K = 2048; N = 2048; }
        else if ((tt -= T_O) < T_FF1) { src = p.w_ff1; dst = (bf16_t*)(p.ws + WS_WFF1); K = 2048; N = 8192; }
        else { tt -= T_FF1; src = p.w_ff2; dst = (bf16_t*)(p.ws + WS_WFF2); K = 8192; N = 2048; }
        const int nkt = K / 64, kt = tt % nkt, nti = tt / nkt, k0 = kt * 64, n0 = nti * 64;
        const int d0 = isin ? win_dst_row(n0) : n0;
        { const int r = tid >> 4, c4 = tid & 15;
#pragma unroll
          for (int i = 0; i < 2; ++i) { const int k = r + 32 * i; const f32x4 v = *(const f32x4*)(src + (size_t)(k0 + k) * N + n0 + c4 * 4);
              tile[k * 65 + c4 * 4 + 0] = v[0]; tile[k * 65 + c4 * 4 + 1] = v[1]; tile[k * 65 + c4 * 4 + 2] = v[2]; tile[k * 65 + c4 * 4 + 3] = v[3]; } }
        __syncthreads();
        { const int n = tid >> 3, kc = tid & 7; float v[8];
#pragma unroll
          for (int j = 0; j < 8; ++j) v[j] = tile[(kc * 8 + j) * 65 + n];
          u32x4 w; w.x = cvt_pk_bf16(v[0], v[1]); w.y = cvt_pk_bf16(v[2], v[3]); w.z = cvt_pk_bf16(v[4], v[5]); w.w = cvt_pk_bf16(v[6], v[7]);
          *(u32x4*)(dst + (size_t)(d0 + n) * K + k0 + kc * 8) = w; }
        __syncthreads();
    }
    float* sl = (float*)lds_;
    float* red = sl + 9 * 2048;
    for (int i = tid; i < 9 * 2048; i += 512) { const float v = i < 8 * 2048 ? p.c_prompt[i] : p.c_sample[i - 8 * 2048]; sl[i] = v / (1.f + __expf(-v)); }
    __syncthreads();
    float* mod = (float*)(p.ws + WS_MOD);
    for (int cgp = blockIdx.x; cgp < 256; cgp += gridDim.x) {
        if (tid < 384) {
            const int cq = tid % 12, kg = tid / 12, j0 = cgp * 48 + cq * 4;
            f32x4 acc[9];
#pragma unroll
            for (int b = 0; b < 9; ++b) acc[b] = (f32x4){0.f, 0.f, 0.f, 0.f};
#pragma unroll 8
            for (int k = kg * 64; k < kg * 64 + 64; ++k) { const f32x4 w = *(const f32x4*)(p.w_ada + (size_t)k * MODW + j0);
#pragma unroll
                for (int b = 0; b < 9; ++b) acc[b] += sl[b * 2048 + k] * w; }
#pragma unroll
            for (int b = 0; b < 9; ++b)
#pragma unroll
                for (int e = 0; e < 4; ++e) red[(kg * 9 + b) * 48 + cq * 4 + e] = acc[b][e];
        }
        __syncthreads();
        for (int i = tid; i < 432; i += 512) { const int b = i / 48, j = i % 48; float s = p.b_ada[cgp * 48 + j];
            for (int kg = 0; kg < 32; ++kg) s += red[(kg * 9 + b) * 48 + j];
            mod[b * MODW + cgp * 48 + j] = s; }
        __syncthreads();
    }
}

template <int KIND>
__device__ __forceinline__ void rows_norm(const Params& p, bf16_t* dst) {
    const int wid = threadIdx.x >> 6, lane = threadIdx.x & 63;
    const float* mod = (const float*)(p.ws + WS_MOD);
    const float* g = KIND == 0 ? p.g_mix : (KIND == 1 ? p.g_mlp : p.g_final);
    for (int grp = blockIdx.x * 8 + wid; grp < NTOK / 16; grp += gridDim.x * 8) {
        const int rbase = grp * 16; const int batch = rbase < NPROMPT ? (rbase >> 11) : 8;
        const float* mb = mod + (size_t)batch * MODW + (KIND == 0 ? 0 : 3 * DM);
        f32x4 mv[8], sv[8];
#pragma unroll
        for (int i = 0; i < 8; ++i) { const int col = i * 256 + lane * 4; mv[i] = *(const f32x4*)(g + col);
            if (KIND < 2) { mv[i] = mv[i] * (1.f + *(const f32x4*)(mb + DM + col)); sv[i] = *(const f32x4*)(mb + col); } else sv[i] = (f32x4){0.f, 0.f, 0.f, 0.f}; }
#pragma unroll 1
        for (int r2 = 0; r2 < 8; ++r2) {
            f32x4 v[2][8];
#pragma unroll
            for (int h = 0; h < 2; ++h) { const int row = rbase + 2 * r2 + h;
                const float* src = KIND == 0 ? (row < NPROMPT ? p.x_prompt + (size_t)row * DM : p.x_sample + (size_t)(row - NPROMPT) * DM) : p.out + (size_t)row * DM;
#pragma unroll
                for (int i = 0; i < 8; ++i) v[h][i] = *(const f32x4*)(src + i * 256 + lane * 4); }
#pragma unroll
            for (int h = 0; h < 2; ++h) { const int row = rbase + 2 * r2 + h;
                float ss = 0.f;
#pragma unroll
                for (int i = 0; i < 8; ++i) ss += v[h][i][0] * v[h][i][0] + v[h][i][1] * v[h][i][1] + v[h][i][2] * v[h][i][2] + v[h][i][3] * v[h][i][3];
                ss = wave_sum(ss);
                const float rstd = rsqrtf(ss * (1.f / DM) + EPS);
#pragma unroll
                for (int i = 0; i < 8; ++i) { const int col = i * 256 + lane * 4; const f32x4 y = v[h][i] * rstd * mv[i] + sv[i];
                    if (KIND < 2) { u32x2 w; w.x = cvt_pk_bf16(y[0], y[1]); w.y = cvt_pk_bf16(y[2], y[3]); *(u32x2*)(dst + (size_t)row * DM + col) = w; }
                    else *(f32x4*)(p.out + (size_t)row * DM + col) = y; } }
        }
    }
}

__device__ __forceinline__ void phase1_side(const Params& p, unsigned char* lds_) {
    const int wid = threadIdx.x >> 6, lane = threadIdx.x & 63;
    float* ss2 = (float*)(p.ws + WS_SS2);
    for (int i = blockIdx.x * 512 + threadIdx.x; i < NTOK; i += gridDim.x * 512) ss2[i] = 0.f;
    const float* mod = (const float*)(p.ws + WS_MOD); const bf16_t* w1t = (const bf16_t*)(p.ws + WS_WFF1); float* b2 = (float*)(p.ws + WS_B2);
    float* sl = (float*)lds_;
    for (int i = threadIdx.x; i < 9 * DM / 4; i += 512) { const int b = i / (DM / 4), k4 = i % (DM / 4); *(f32x4*)(sl + b * DM + k4 * 4) = *(const f32x4*)(mod + (size_t)b * MODW + 3 * DM + k4 * 4); }
    __syncthreads();
    for (int n = blockIdx.x * 8 + wid; n < DFF; n += gridDim.x * 8) {
        float w[32];
#pragma unroll
        for (int i = 0; i < 4; ++i) { const u32x4 v = *(const u32x4*)(w1t + (size_t)n * DM + i * 512 + lane * 8);
#pragma unroll
            for (int j = 0; j < 4; ++j) { w[i * 8 + 2 * j] = __uint_as_float(v[j] << 16); w[i * 8 + 2 * j + 1] = __uint_as_float(v[j] & 0xffff0000u); } }
        float acc[9];
#pragma unroll
        for (int b = 0; b < 9; ++b) { float a = 0.f;
#pragma unroll
            for (int i = 0; i < 4; ++i) { const f32x4 s0 = *(const f32x4*)(sl + b * DM + i * 512 + lane * 8), s1 = *(const f32x4*)(sl + b * DM + i * 512 + lane * 8 + 4);
                a += s0[0] * w[i * 8] + s0[1] * w[i * 8 + 1] + s0[2] * w[i * 8 + 2] + s0[3] * w[i * 8 + 3] + s1[0] * w[i * 8 + 4] + s1[1] * w[i * 8 + 5] + s1[2] * w[i * 8 + 6] + s1[3] * w[i * 8 + 7]; }
            acc[b] = a; asm volatile("" ::: "memory"); }
#pragma unroll
        for (int b = 0; b < 9; ++b) acc[b] = wave_sum(acc[b]);
        if (lane == 0) {
#pragma unroll
            for (int b = 0; b < 9; ++b) b2[(size_t)b * DFF + n] = acc[b]; }
    }
    __syncthreads();
}

__device__ __forceinline__ void phase_rope(const Params& p) {
    const int wid = threadIdx.x >> 6, lane = threadIdx.x & 63, i32 = lane & 31;
    bf16_t* proj = (bf16_t*)(p.ws + WS_PROJ);
    const double inv = exp2(-(double)i32 * (13.287712379549449 / 32.0));
    f32x4 g0 = *(const f32x4*)(p.g_kv + lane * 8), g1 = *(const f32x4*)(p.g_kv + lane * 8 + 4);
    const int stride = gridDim.x * 8;
    for (int t0 = blockIdx.x * 8 + wid; t0 < NTOK; t0 += 2 * stride) {
        float qa[2][4], qb[2][4], ka[2], kb[2]; u32x4 cv[2];
#pragma unroll
        for (int h = 0; h < 2; ++h) { const int t = t0 + h * stride; if (t < NTOK) { const bf16_t* row = proj + (size_t)t * LDP;
#pragma unroll
            for (int j = 0; j < 4; ++j) { const bf16_t* q = row + C_QR + (2 * j + (lane >> 5)) * 64 + i32; qa[h][j] = bf2f(q[0]); qb[h][j] = bf2f(q[32]); }
            { const bf16_t* q = row + C_KR + i32; ka[h] = bf2f(q[0]); kb[h] = bf2f(q[32]); }
            cv[h] = *(const u32x4*)(row + C_CKV + lane * 8); } }
#pragma unroll
        for (int h = 0; h < 2; ++h) { const int t = t0 + h * stride; if (t < NTOK) {
            const int pos = t < NPROMPT ? (t & (SEQP - 1)) : t - NPROMPT;
            bf16_t* row = proj + (size_t)t * LDP;
            double a = (double)pos * inv; a -= 6.283185307179586 * rint(a * 0.15915494309189535);
            const float af = (float)a, sn = sinf(af), cs = cosf(af);
#pragma unroll
            for (int j = 0; j < 4; ++j) { bf16_t* q = row + C_QR + (2 * j + (lane >> 5)) * 64 + i32; const float x1 = qa[h][j], x2 = qb[h][j];
                q[0] = f2bf(x1 * cs - x2 * sn); q[32] = f2bf(x1 * sn + x2 * cs); }
            if (lane < 32) { bf16_t* q = row + C_KR + i32; const float x1 = ka[h], x2 = kb[h]; q[0] = f2bf(x1 * cs - x2 * sn); q[32] = f2bf(x1 * sn + x2 * cs); }
            float x[8];
#pragma unroll
            for (int j = 0; j < 4; ++j) { x[2 * j] = __uint_as_float(cv[h][j] << 16); x[2 * j + 1] = __uint_as_float(cv[h][j] & 0xffff0000u); }
            float ss = 0.f;
#pragma unroll
            for (int j = 0; j < 8; ++j) ss += x[j] * x[j];
            ss = wave_sum(ss);
            const float rstd = rsqrtf(ss * (1.f / 512.f) + EPS);
            u32x4 w; w.x = cvt_pk_bf16(x[0] * rstd * g0[0], x[1] * rstd * g0[1]); w.y = cvt_pk_bf16(x[2] * rstd * g0[2], x[3] * rstd * g0[3]);
            w.z = cvt_pk_bf16(x[4] * rstd * g1[0], x[5] * rstd * g1[1]); w.w = cvt_pk_bf16(x[6] * rstd * g1[2], x[7] * rstd * g1[3]);
            *(u32x4*)(row + C_CKV + lane * 8) = w; } }
    }
}

__device__ __forceinline__ int t5_bucket(int rel) {
    const int n = rel < 0 ? -rel : rel; int b;
    if (n < 8) b = n; else if (n < 12) b = 8; else if (n < 16) b = 9; else if (n < 23) b = 10; else if (n < 32) b = 11; else if (n < 46) b = 12; else if (n < 64) b = 13; else if (n < 91) b = 14; else b = 15;
    return b + (rel > 0 ? 16 : 0);
}

#ifndef NB_ITEMS
#define NB_ITEMS 1024
#endif
#ifndef NA_ITEMS
#define NA_ITEMS 1024
#endif
__device__ __forceinline__ void phase_attn(const Params& p, char* lds, int vbid) {
    bf16_t* proj = (bf16_t*)(p.ws + WS_PROJ); const bf16_t* kvb = (const bf16_t*)(p.ws + WS_R2);
    const int G = gridDim.x, bid = vbid;
#ifdef ATT_TWICE
    for (int rep = 0; rep < 2; ++rep) {
    bf16_t* oproj = rep == 0 ? (bf16_t*)p.out : proj;
#else
    bf16_t* oproj = proj;
    {
#endif
    for (int it = bid; it < NB_ITEMS; it += G) {
        const int h = it & 7; int row0, kbase, S;
        if (it < 512) { const int qb = it >> 3; row0 = NPROMPT + qb * 256; kbase = NPROMPT; S = SEQS; }
        else { const int r = (it - 512) >> 3; const int seq = r >> 3, qb = r & 7; row0 = seq * SEQP + qb * 256; kbase = seq * SEQP; S = SEQP; }
        __syncthreads();
        bf16_t* Qb = proj + (size_t)row0 * LDP + C_QN + h * 128;
        att::attn_item<1>(Qb, proj + (size_t)row0 * LDP + C_QR + h * 64, kvb + (size_t)kbase * 2048 + h * 256, proj + (size_t)kbase * LDP + C_KR,
                          kvb + (size_t)kbase * 2048 + h * 256 + 128, oproj + (size_t)row0 * LDP + C_QN + h * 128, S / 64, 0, -1e30f, 0.f, lds);
    }
    float* bl = (float*)(lds + att::OFF_BL);
    for (int it = bid; it < NA_ITEMS; it += G) {
        const int h = it & 7, kvh = h >> 2, row0 = (it >> 3) * 256;
        const int seq0 = row0 < NPROMPT ? (row0 & ~(SEQP - 1)) : NPROMPT, S = row0 < NPROMPT ? SEQP : SEQS, pos0 = row0 - seq0;
        const int kf = pos0 - 128 < 0 ? 0 : pos0 - 128, kl = pos0 + 384 > S ? S : pos0 + 384;
        __syncthreads();
        for (int i = threadIdx.x; i < 768; i += 512) { const int rel = i - 384; bl[i] = (rel >= -128 && rel <= 128) ? p.rel_bias[t5_bucket(rel) * 8 + h] * LOG2E : -1e30f; }
        bf16_t* Qb = proj + (size_t)row0 * LDP + C_QA + h * 128;
        att::attn_item<0>(Qb, nullptr, proj + (size_t)(seq0 + kf) * LDP + C_KA + kvh * 128, nullptr, proj + (size_t)(seq0 + kf) * LDP + C_VA + kvh * 128, oproj + (size_t)row0 * LDP + C_QA + h * 128,
                          (kl - kf) / 64, kf - pos0, p.sink[h] * LOG2E, 1.f, lds);
    }
    }
}

__global__ void __launch_bounds__(512) fwd_mega(Params p) {
    extern __shared__ __attribute__((aligned(16))) unsigned char lds[];
    cg::grid_group grid = cg::this_grid();
    const int lo = p.ph_lo, hi = p.ph_hi;
#ifndef PH_MASK
#define PH_MASK 0x1ffff
#endif
#define IN(k) (((PH_MASK >> (k)) & 1) && lo <= (k) && (k) < hi)
#define SEAM(k) do { if (IN(k) && IN((k) + 1)) { if (p.coop == 2) grid.sync(); else xcd_barrier(xbar); } } while (0)
    { volatile LAS unsigned* st = (volatile LAS unsigned*)((LAS unsigned char*)lds + LDS_XB); if (threadIdx.x == 0) { st[0] = 0u; st[1] = 0u; st[2] = 0u; st[3] = 0u; } }
    __syncthreads();
    XcdBarrier xbar = xcd_barrier_post((unsigned*)(p.ws + WS_BAR), (volatile LAS unsigned*)((LAS unsigned char*)lds + LDS_XB));
    bf16_t* proj = (bf16_t*)(p.ws + WS_PROJ); bf16_t* r2 = (bf16_t*)(p.ws + WS_R2);
    const float* mod = (const float*)(p.ws + WS_MOD);
    LAS unsigned char* l3 = (LAS unsigned char*)lds;

    if (IN(0)) phase0(p, lds);
    SEAM(0);
    int vbid = blockIdx.x;
    if (IN(0) && IN(1)) {
        volatile LAS unsigned* st = (volatile LAS unsigned*)((LAS unsigned char*)lds + LDS_XB);
        if (threadIdx.x == 0) { unsigned* bar = (unsigned*)(p.ws + WS_BAR); const unsigned G = gridDim.x; bool ok = (G % 8u) == 0u;
            for (unsigned j = 0; j < 16; ++j) { const unsigned cnt = xb_ld(&bar[XB_XCNT(j)]); ok = ok && (j < 8 ? cnt == G / 8u : cnt == 0u); }
            st[3] = ok ? (st[2] * 8u + xbar.x) : (unsigned)blockIdx.x; }
        __syncthreads();
        vbid = (int)st[3];
    }
#ifdef XTRA_SYNC
    for (int e = 0; e < XTRA_SYNC; ++e) grid.sync();
#endif
    if (IN(1)) { phase1_side(p, lds); rows_norm<0>(p, r2); }
    SEAM(1);
    if (IN(2)) { pg8::Gemm g{r2, DM, (const bf16_t*)(p.ws + WS_WIN), NTOK, LDP, DM}; pg8::StaticOrder S; S.init(NTOK, LDP, gridDim.x, vbid);
        pg8::EpiBf16<0> E{proj, LDP}; pg8::gemm_phase(l3, g, S, E); }
    SEAM(2);
    if (IN(3)) phase_rope(p);
    SEAM(3);
    if (IN(4)) { pg8::Gemm g{proj + C_CKV, LDP, (const bf16_t*)(p.ws + WS_WKVB), NTOK, 2048, 512}; pg8::StaticOrder S; S.init(NTOK, 2048, gridDim.x, vbid);
        pg8::EpiBf16<0> E{r2, 2048}; pg8::gemm_phase(l3, g, S, E); }
    SEAM(4);
    if (IN(5)) phase_attn(p, (char*)lds, vbid);
    SEAM(5);
    if (IN(6)) { pg8::Gemm g{proj, LDP, (const bf16_t*)(p.ws + WS_WO), NTOK, DM, DM}; pg8::StaticOrder S; S.init(NTOK, DM, gridDim.x, vbid);
        pg8::EpiWo E{p.x_prompt, p.x_sample, p.out, mod, p.g_mlp, r2, (float*)(p.ws + WS_SS2)}; pg8::gemm_phase(l3, g, S, E); }
    SEAM(6);
    const bool fuse_final = (gridDim.x == 256) && (hi - lo == NPHASE);
#pragma unroll 1
    for (int c = 0; c < 4; ++c) {
        if (IN(8 + 2 * c)) { pg8::Gemm g{r2 + (size_t)c * FCH * DM, DM, (const bf16_t*)(p.ws + WS_WFF1), FCH, DFF, DM}; pg8::StaticOrder S; S.init(FCH, DFF, gridDim.x, vbid);
            pg8::EpiFfn1 E{proj, (const float*)(p.ws + WS_SS2), (const float*)(p.ws + WS_B2), c * FCH}; pg8::gemm_phase(l3, g, S, E); }
        SEAM(8 + 2 * c);
        if (IN(9 + 2 * c)) { pg8::Gemm g{proj, DFF, (const bf16_t*)(p.ws + WS_WFF2), FCH, DM, DFF};   pg8::StaticOrder S; S.init(FCH, DM, gridDim.x, vbid);
            if (fuse_final) { pg8::EpiFinal E{p.out, mod + 5 * DM, p.g_final, (float*)(p.ws + WS_SS), c * FCH, xbar}; pg8::gemm_phase(l3, g, S, E); }
            else { pg8::EpiResGate E{p.out, p.out + (size_t)NPROMPT * DM, p.out, mod + 5 * DM, c * FCH}; pg8::gemm_phase(l3, g, S, E); } }
        if (!fuse_final) SEAM(9 + 2 * c);
    }
    if (IN(16) && !fuse_final) rows_norm<2>(p, nullptr);
#undef IN
#undef SEAM
}

#ifndef N_LAUNCHES
#define N_LAUNCHES 1
#endif
extern "C" void kernel_launch(void* const* d_in, const int* in_sizes, int n_in, void* d_out, int out_size, void* d_ws, size_t ws_size, hipStream_t stream) {
    static int grid = 0;
    if (grid == 0) {
        if (n_in != 17 || ws_size < WS_END) { fprintf(stderr, "kernel_launch: n_in %d ws %zu (need %zu)\n", n_in, ws_size, (size_t)WS_END); grid = -1; return; }
        int dev = 0, cus = 0, per_cu = 0;
        hipGetDevice(&dev); hipDeviceGetAttribute(&cus, hipDeviceAttributeMultiprocessorCount, dev);
        if (hipFuncSetAttribute((const void*)fwd_mega, hipFuncAttributeMaxDynamicSharedMemorySize, LDS_BYTES) != hipSuccess) { fprintf(stderr, "kernel_launch: hipFuncSetAttribute failed\n"); grid = -1; return; }
        if (hipOccupancyMaxActiveBlocksPerMultiprocessor(&per_cu, (const void*)fwd_mega, 512, LDS_BYTES) != hipSuccess || per_cu < 1) { fprintf(stderr, "kernel_launch: occupancy query says %d\n", per_cu); per_cu = 1; }
        (void)hipGetLastError();
        grid = cus * 1;
        fprintf(stderr, "kernel_launch: cus %d per_cu %d grid %d ws %zu\n", cus, per_cu, grid, ws_size);
    }
    if (grid < 0) return;
    Params p{};
    p.x_prompt = (const float*)d_in[0]; p.x_sample = (const float*)d_in[1]; p.c_prompt = (const float*)d_in[2]; p.c_sample = (const float*)d_in[3];
    p.w_ada = (const float*)d_in[4]; p.b_ada = (const float*)d_in[5]; p.g_mix = (const float*)d_in[6]; p.w_in = (const float*)d_in[7]; p.sink = (const float*)d_in[8];
    p.g_kv = (const float*)d_in[9]; p.w_kv_b = (const float*)d_in[10]; p.w_o = (const float*)d_in[11]; p.g_mlp = (const float*)d_in[12]; p.w_ff1 = (const float*)d_in[13];
    p.w_ff2 = (const float*)d_in[14]; p.rel_bias = (const float*)d_in[15]; p.g_final = (const float*)d_in[16];
    p.out = (float*)d_out; p.ws = (unsigned char*)d_ws;
#if N_LAUNCHES == 1
    (void)hipMemsetAsync((char*)d_ws + WS_BAR, 0, 16384, stream);
    p.ph_lo = 0; p.ph_hi = NPHASE; p.coop = 1;
    void* args[] = {&p};
    hipError_t e = hipLaunchCooperativeKernel((void*)fwd_mega, dim3(grid), dim3(512), args, LDS_BYTES, stream);
    if (e != hipSuccess) fprintf(stderr, "cooperative launch failed: %s (grid %d)\n", hipGetErrorString(e), grid);
#else
    for (int k = 0; k < NPHASE; ++k) { p.ph_lo = k; p.ph_hi = k + 1; p.coop = 0;
        hipLaunchKernelGGL(fwd_mega, dim3(grid), dim3(512), LDS_BYTES, stream, p); }
#endif
}
```

```cpp
#include <hip/hip_runtime.h>
#include <hip/hip_cooperative_groups.h>
#include <cstdio>
#include <cstdint>
namespace cg = cooperative_groups;

#define LAS __attribute__((address_space(3)))
typedef unsigned short bf16_t;
typedef short bf16x8 __attribute__((ext_vector_type(8)));
typedef short s16x4 __attribute__((ext_vector_type(4)));
typedef float f32x4 __attribute__((ext_vector_type(4)));
typedef float f32x2 __attribute__((ext_vector_type(2)));
typedef float f32x16 __attribute__((ext_vector_type(16)));
typedef unsigned u32x4 __attribute__((ext_vector_type(4)));
typedef unsigned u32x2 __attribute__((ext_vector_type(2)));

constexpr int DM = 2048, NTOK = 32768, NPROMPT = 16384, SEQP = 2048, SEQS = 16384, DFF = 8192;
constexpr int LDP = 3840;
constexpr int C_QA = 0, C_QN = 1024, C_KA = 2048, C_VA = 2304, C_QR = 2560, C_CKV = 3072, C_KR = 3584;
constexpr int MODW = 6 * DM;
constexpr int FCH = 8192;
constexpr float EPS = 1e-6f;
constexpr float LOG2E = 1.4426950408889634f;

constexpr size_t WS_WIN = 0;
constexpr size_t WS_WKVB = WS_WIN + (size_t)LDP * DM * 2;
constexpr size_t WS_WO = WS_WKVB + (size_t)2048 * 512 * 2;
constexpr size_t WS_WFF1 = WS_WO + (size_t)DM * DM * 2;
constexpr size_t WS_WFF2 = WS_WFF1 + (size_t)DFF * DM * 2;
constexpr size_t WS_MOD = WS_WFF2 + (size_t)DM * DFF * 2;
constexpr size_t WS_PROJ = WS_MOD + (size_t)9 * MODW * 4 + 1024;
constexpr size_t WS_R2 = WS_PROJ + (size_t)NTOK * LDP * 2;
constexpr size_t WS_BAR = WS_R2 + (size_t)NTOK * DM * 2;
constexpr size_t WS_SS = WS_BAR + 16384;
constexpr size_t WS_SS2 = WS_SS + (size_t)NTOK * 8 * 4;
constexpr size_t WS_B2 = WS_SS2 + (size_t)NTOK * 4;
constexpr size_t WS_END = WS_B2 + (size_t)9 * DFF * 4;
constexpr int LDS_XB = 139264;
constexpr int LDS_BYTES = 139264 + 256;
constexpr int NPHASE = 17;

struct Params {
    const float* x_prompt; const float* x_sample; const float* c_prompt; const float* c_sample;
    const float* w_ada; const float* b_ada; const float* g_mix; const float* w_in; const float* sink;
    const float* g_kv; const float* w_kv_b; const float* w_o; const float* g_mlp; const float* w_ff1; const float* w_ff2;
    const float* rel_bias; const float* g_final;
    float* out; unsigned char* ws;
    int ph_lo, ph_hi, coop, pad;
};

__device__ __forceinline__ unsigned cvt_pk_bf16(float lo, float hi) { unsigned r; asm volatile("v_cvt_pk_bf16_f32 %0, %1, %2" : "=v"(r) : "v"(lo), "v"(hi)); return r; }
typedef __bf16 bf16x2_t __attribute__((ext_vector_type(2)));
__device__ __forceinline__ unsigned cvt_pk_nv(float lo, float hi) { f32x2 v = {lo, hi}; bf16x2_t c = __builtin_convertvector(v, bf16x2_t); return *reinterpret_cast<unsigned*>(&c); }
__device__ __forceinline__ float bf2f(bf16_t b) { return __uint_as_float(((unsigned)b) << 16); }
__device__ __forceinline__ bf16_t f2bf(float f) { return (bf16_t)(cvt_pk_bf16(f, 0.f) & 0xffffu); }
__device__ __forceinline__ float wave_sum(float v) {
#pragma unroll
    for (int o = 32; o >= 1; o >>= 1) v += __shfl_xor(v, o);
    return v;
}

#define XB_TMO      128
#define XB_XCNT(j)  (256  + 64 * (j))
#define XB_XSUB(j)  (1280 + 64 * (j))
#define XB_XGEN(j)  (2304 + 64 * (j))
#define XB_TOP      3328
#define XB_TOPGEN   3392
#define XCD_BAR_WORDS 3456
#define XB_SPIN_CAP (1u << 20)
__device__ __forceinline__ unsigned xb_ld(unsigned* p)              { return __hip_atomic_load(p, __ATOMIC_RELAXED, __HIP_MEMORY_SCOPE_AGENT); }
__device__ __forceinline__ unsigned xb_add(unsigned* p, unsigned v) { return __hip_atomic_fetch_add(p, v, __ATOMIC_RELAXED, __HIP_MEMORY_SCOPE_AGENT); }
__device__ __forceinline__ unsigned xb_xcc_id() { return (unsigned)__builtin_amdgcn_s_getreg((3 << 11) | 20) & 0xFu; }
#define XB_SPIN(cond, bar) do { unsigned _sp = 0; while (cond) { __builtin_amdgcn_s_sleep(1); \
    if ((++_sp & 255u) == 0u) { if (xb_ld(&(bar)[XB_TMO])) break; if (_sp > XB_SPIN_CAP) { atomicAdd(&(bar)[XB_TMO], 1u); break; } } } } while (0)
struct XcdBarrier { unsigned* bar; unsigned x; volatile LAS unsigned* st; };
__device__ __forceinline__ XcdBarrier xcd_barrier_post(unsigned* bar, volatile LAS unsigned* st) {
    XcdBarrier b; b.bar = bar; b.x = xb_xcc_id(); b.st = st;
    if (threadIdx.x == 0) st[2] = xb_add(&bar[XB_XCNT(b.x)], 1u);
    return b;
}
__device__ __forceinline__ void xcd_barrier_complete(unsigned* bar, unsigned x, unsigned& nloc, unsigned& nx) {
    const unsigned G = gridDim.x * gridDim.y * gridDim.z;
    unsigned sum, cnt, mine, sp = 0u;
    for (;;) {
        sum = 0u; cnt = 0u; mine = 0u;
#pragma unroll
        for (unsigned j = 0; j < 16; ++j) { const unsigned c = xb_ld(&bar[XB_XCNT(j)]); sum += c; cnt += (c > 0u) ? 1u : 0u; mine = (j == x) ? c : mine; }
        if (sum == G) break;
        __builtin_amdgcn_s_sleep(1);
        if ((++sp & 255u) == 0u) { if (xb_ld(&bar[XB_TMO])) break; if (sp > XB_SPIN_CAP) { atomicAdd(&bar[XB_TMO], 1u); break; } }
    }
    nloc = mine > 0u ? mine : 1u; nx = cnt > 0u ? cnt : 1u;
}
__device__ __forceinline__ void xcd_barrier(const XcdBarrier& b) {
    asm volatile("s_waitcnt vmcnt(0)" ::: "memory");
    __syncthreads();
    if (threadIdx.x == 0) {
        unsigned* bar = b.bar;
        __builtin_amdgcn_s_waitcnt(0);
        unsigned nloc = b.st[0], nx = b.st[1];
        if (nloc == 0u) { xcd_barrier_complete(bar, b.x, nloc, nx); b.st[0] = nloc; b.st[1] = nx; }
        const unsigned old = xb_add(&bar[XB_XSUB(b.x)], 1u);
        const unsigned gen = old / nloc;
        if (old + 1u == (gen + 1u) * nloc) {
            __builtin_amdgcn_fence(__ATOMIC_RELEASE, "agent");
            asm volatile("s_waitcnt vmcnt(0)" ::: "memory");
            const unsigned og = xb_add(&bar[XB_TOP], 1u);
            const unsigned tg = og / nx;
            if (og + 1u == (tg + 1u) * nx) xb_add(&bar[XB_TOPGEN], 1u);
            else XB_SPIN(xb_ld(&bar[XB_TOPGEN]) == tg, bar);
            __builtin_amdgcn_fence(__ATOMIC_ACQUIRE, "agent");
            xb_add(&bar[XB_XGEN(b.x)], 1u);
            asm volatile("s_waitcnt vmcnt(0)" ::: "memory");
        } else {
            XB_SPIN(xb_ld(&bar[XB_XGEN(b.x)]) == gen, bar);
            __builtin_amdgcn_fence(__ATOMIC_ACQUIRE, "agent");
            asm volatile("s_waitcnt vmcnt(0)" ::: "memory");
        }
    }
    __syncthreads();
}


namespace pg8 {
constexpr int BM = 256, BK = 64, HALF = 128, HTB = HALF * BK * 2, STAGE_BYTES = 8 * HTB, NXCD = 8, WGM = 8;
__host__ __device__ __forceinline__ int lds_byte(int r, int c) { const int st = (r >> 4) * 2 + (c >> 5), rr = r & 15, cc = c & 31, ob = rr * 64 + cc * 2; return st * 1024 + (ob ^ (((ob >> 9) & 1) << 5)); }
__host__ __device__ __forceinline__ void stage_rc(int b, int& R, int& C) { const int st = b / 1024, sb = b % 1024, swz = sb ^ (((sb >> 9) & 1) << 5); R = (st >> 1) * 16 + swz / 64; C = (st & 1) * 32 + (swz % 64) / 2; }
__host__ __device__ __forceinline__ int perm32(int rho) { const int n = rho >> 4, i = rho & 15; return 8 * (i >> 2) + 4 * n + (i & 3); }

struct Unit { int pm, pn; };
struct Gemm { const bf16_t* A; int lda; const bf16_t* Bt; int M, N, K; };

struct StaticOrder {
    int nM, nN, nwg, G, c;
    __device__ void init(int M, int N, int G_, int c_) { nM = M / BM; nN = N / BM; nwg = nM * nN; G = G_; c = c_; }
    __device__ bool next(int i, Unit& u) const {
        const long L = (long)i * G + c; if (L >= nwg) return false;
        int wgid = (int)L; { const int q = nwg / NXCD, r = nwg % NXCD, xcd = wgid % NXCD, off = wgid / NXCD; wgid = (xcd < r ? xcd * (q + 1) : r * (q + 1) + (xcd - r) * q) + off; }
        const int nig = WGM * nN, gid = wgid / nig, fm = gid * WGM, gsz = (nM - fm) < WGM ? (nM - fm) : WGM;
        u.pm = fm + ((wgid % nig) % gsz); u.pn = (wgid % nig) / gsz; return true;
    }
};

template <int ACT  > struct EpiBf16 {
    static constexpr bool PERM = true, AFTER_DRAIN = false;
    bf16_t* O; int ldc;
    __device__ __forceinline__ void operator()(const f32x4 (&acc)[2][2][4][2], const Unit& u, int wr, int wc, int fr, int fq) const {
        const int row0 = u.pm * BM + wr * 64 + fr; const int col0 = u.pn * BM + wc * 32 + 8 * fq;
#pragma unroll
        for (int ai = 0; ai < 2; ++ai)
#pragma unroll
            for (int m = 0; m < 4; ++m) { bf16_t* rowp = O + (size_t)(row0 + ai * HALF + m * 16) * ldc + col0;
#pragma unroll
                for (int bj = 0; bj < 2; ++bj) { f32x4 v0 = acc[ai][bj][m][0], v1 = acc[ai][bj][m][1];
                    if (ACT == 3) {
#pragma unroll
                        for (int j = 0; j < 4; ++j) { const float a = fmaxf(v0[j], 0.f), b = fmaxf(v1[j], 0.f); v0[j] = a * a; v1[j] = b * b; } }
                    u32x4 w; w.x = cvt_pk_bf16(v0[0], v0[1]); w.y = cvt_pk_bf16(v0[2], v0[3]); w.z = cvt_pk_bf16(v1[0], v1[1]); w.w = cvt_pk_bf16(v1[2], v1[3]);
                    *(u32x4*)(rowp + bj * HALF) = w; } }
    }
};
struct EpiResGate {
    static constexpr bool PERM = false, AFTER_DRAIN = false;
    const float* xa; const float* xb; float* out; const float* gate; int row_off;
    __device__ __forceinline__ void operator()(const f32x4 (&acc)[2][2][4][2], const Unit& u, int wr, int wc, int fr, int fq) const {
        const int trow = row_off + u.pm * BM; const int batch = trow < NPROMPT ? (trow >> 11) : 8;
        const int row0 = trow + wr * 64 + fr, col0 = u.pn * BM + wc * 32 + 4 * fq;
        const float* gp = gate + (size_t)batch * MODW + col0;
        f32x4 gv[2][2];
#pragma unroll
        for (int bj = 0; bj < 2; ++bj)
#pragma unroll
            for (int n = 0; n < 2; ++n) gv[bj][n] = *(const f32x4*)(gp + bj * HALF + n * 16);
#pragma unroll
        for (int ai = 0; ai < 2; ++ai)
#pragma unroll
            for (int m = 0; m < 4; ++m) { const int row = row0 + ai * HALF + m * 16;
                const float* src = (row < NPROMPT ? xa + (size_t)row * DM : xb + (size_t)(row - NPROMPT) * DM) + col0; float* dst = out + (size_t)row * DM + col0;
#pragma unroll
                for (int bj = 0; bj < 2; ++bj)
#pragma unroll
                    for (int n = 0; n < 2; ++n) { const f32x4 b = *(const f32x4*)(src + bj * HALF + n * 16); *(f32x4*)(dst + bj * HALF + n * 16) = b + gv[bj][n] * acc[ai][bj][m][n]; } }
    }
};

struct EpiWo {
    static constexpr bool PERM = false, AFTER_DRAIN = false;
    const float* xa; const float* xb; float* out; const float* mod; const float* gmlp; bf16_t* U; float* ss2;
    __device__ __forceinline__ void operator()(const f32x4 (&acc)[2][2][4][2], const Unit& u, int wr, int wc, int fr, int fq) const {
        const int trow = u.pm * BM; const int batch = trow < NPROMPT ? (trow >> 11) : 8;
        const int row0 = trow + wr * 64 + fr, col0 = u.pn * BM + wc * 32 + 4 * fq;
        const float* mb = mod + (size_t)batch * MODW + col0;
        f32x4 gv[2][2], mv[2][2];
#pragma unroll
        for (int bj = 0; bj < 2; ++bj)
#pragma unroll
            for (int n = 0; n < 2; ++n) { gv[bj][n] = *(const f32x4*)(mb + 2 * DM + bj * HALF + n * 16);
                mv[bj][n] = *(const f32x4*)(gmlp + col0 + bj * HALF + n * 16) * (1.f + *(const f32x4*)(mb + 4 * DM + bj * HALF + n * 16)); }
        f32x4 xr[2][4];
#define WO_LOAD(buf, g) do { const int row_ = row0 + ((g) >> 2) * HALF + ((g) & 3) * 16; \
            const float* src_ = (row_ < NPROMPT ? xa + (size_t)row_ * DM : xb + (size_t)(row_ - NPROMPT) * DM) + col0; \
            _Pragma("unroll") for (int q_ = 0; q_ < 4; ++q_) xr[buf][q_] = *(const f32x4*)(src_ + (q_ >> 1) * HALF + (q_ & 1) * 16); } while (0)
        WO_LOAD(0, 0);
#pragma unroll
        for (int g = 0; g < 8; ++g) { const int ai = g >> 2, m = g & 3; const int row = row0 + ai * HALF + m * 16;
            if (g + 1 < 8) WO_LOAD((g + 1) & 1, g + 1);
            float* dst = out + (size_t)row * DM + col0; bf16_t* ud = U + (size_t)row * DM + col0; float sq = 0.f;
#pragma unroll
            for (int bj = 0; bj < 2; ++bj)
#pragma unroll
                for (int n = 0; n < 2; ++n) { const f32x4 v = xr[g & 1][bj * 2 + n] + gv[bj][n] * acc[ai][bj][m][n];
                    *(f32x4*)(dst + bj * HALF + n * 16) = v; sq += v[0] * v[0] + v[1] * v[1] + v[2] * v[2] + v[3] * v[3];
                    const f32x4 uu = v * mv[bj][n]; u32x2 w; w.x = cvt_pk_bf16(uu[0], uu[1]); w.y = cvt_pk_bf16(uu[2], uu[3]); *(u32x2*)(ud + bj * HALF + n * 16) = w; }
            sq += __shfl_xor(sq, 16); sq += __shfl_xor(sq, 32);
            if (fq == 0) (void)__hip_atomic_fetch_add(ss2 + row, sq, __ATOMIC_RELAXED, __HIP_MEMORY_SCOPE_AGENT); }
#undef WO_LOAD
    }
};
struct EpiFfn1 {
    static constexpr bool PERM = true, AFTER_DRAIN = false;
    bf16_t* O; const float* ss2; const float* bias2; int row_off;
    __device__ __forceinline__ void operator()(const f32x4 (&acc)[2][2][4][2], const Unit& u, int wr, int wc, int fr, int fq) const {
        const int trow = row_off + u.pm * BM; const int batch = trow < NPROMPT ? (trow >> 11) : 8;
        const int row0 = u.pm * BM + wr * 64 + fr; const int col0 = u.pn * BM + wc * 32 + 8 * fq;
        const float* bp = bias2 + (size_t)batch * DFF + col0;
        f32x4 bv[2][2];
#pragma unroll
        for (int bj = 0; bj < 2; ++bj)
#pragma unroll
            for (int n = 0; n < 2; ++n) bv[bj][n] = *(const f32x4*)(bp + bj * HALF + 4 * n);
        float ssv[2][4];
#pragma unroll
        for (int ai = 0; ai < 2; ++ai)
#pragma unroll
            for (int m = 0; m < 4; ++m) ssv[ai][m] = ss2[row_off + row0 + ai * HALF + m * 16];
#pragma unroll
        for (int ai = 0; ai < 2; ++ai)
#pragma unroll
            for (int m = 0; m < 4; ++m) asm volatile("" : "+v"(ssv[ai][m]));
#pragma unroll
        for (int ai = 0; ai < 2; ++ai)
#pragma unroll
            for (int m = 0; m < 4; ++m) { const int lrow = row0 + ai * HALF + m * 16; bf16_t* rowp = O + (size_t)lrow * DFF + col0;
                const float rs = rsqrtf(ssv[ai][m] * (1.f / DM) + EPS);
#pragma unroll
                for (int bj = 0; bj < 2; ++bj) { f32x4 v0 = acc[ai][bj][m][0] * rs + bv[bj][0], v1 = acc[ai][bj][m][1] * rs + bv[bj][1];
#pragma unroll
                    for (int j = 0; j < 4; ++j) { const float a = fmaxf(v0[j], 0.f), b = fmaxf(v1[j], 0.f); v0[j] = a * a; v1[j] = b * b; }
                    u32x4 w; w.x = cvt_pk_bf16(v0[0], v0[1]); w.y = cvt_pk_bf16(v0[2], v0[3]); w.z = cvt_pk_bf16(v1[0], v1[1]); w.w = cvt_pk_bf16(v1[2], v1[3]);
                    *(u32x4*)(rowp + bj * HALF) = w; } }
    }
};
struct EpiFinal {
    static constexpr bool PERM = false, AFTER_DRAIN = true;
    float* out; const float* gate; const float* gfinal; float* sspart; int row_off; XcdBarrier bar;
    __device__ __forceinline__ void fused(f32x4 (&acc)[2][2][4][2], const Unit& u, int wr, int wc, int fr, int fq, LAS unsigned char* lds) const {
        LAS float* P = (LAS float*)lds;
        LAS float* S = (LAS float*)(lds + 4096);
        const int trow = row_off + u.pm * BM; const int batch = trow < NPROMPT ? (trow >> 11) : 8;
        const int row0 = trow + wr * 64 + fr, col0 = u.pn * BM + wc * 32 + 4 * fq;
        {
            const float* gp = gate + (size_t)batch * MODW + col0;
            f32x4 gv[2][2];
#pragma unroll
            for (int bj = 0; bj < 2; ++bj)
#pragma unroll
                for (int n = 0; n < 2; ++n) gv[bj][n] = *(const f32x4*)(gp + bj * HALF + n * 16);
            f32x4 xr[3][4];
#define FN_LOAD(buf, g) do { const float* src_ = out + (size_t)(row0 + ((g) >> 2) * HALF + ((g) & 3) * 16) * DM + col0; \
                _Pragma("unroll") for (int q_ = 0; q_ < 4; ++q_) xr[buf][q_] = *(const f32x4*)(src_ + (q_ >> 1) * HALF + (q_ & 1) * 16); } while (0)
            FN_LOAD(0, 0); FN_LOAD(1, 1);
#pragma unroll
            for (int g = 0; g < 8; ++g) { const int ai = g >> 2, m = g & 3; float sq = 0.f;
                if (g + 2 < 8) FN_LOAD((g + 2) % 3, g + 2);
#pragma unroll
                for (int bj = 0; bj < 2; ++bj)
#pragma unroll
                    for (int n = 0; n < 2; ++n) { const f32x4 v = xr[g % 3][bj * 2 + n] + gv[bj][n] * acc[ai][bj][m][n]; acc[ai][bj][m][n] = v;
                        sq += v[0] * v[0] + v[1] * v[1] + v[2] * v[2] + v[3] * v[3]; }
                sq += __shfl_xor(sq, 16); sq += __shfl_xor(sq, 32);
                if (fq == 0) P[(ai * HALF + wr * 64 + m * 16 + fr) * 4 + wc] = sq; }
#undef FN_LOAD
        }
        __syncthreads();
        if (threadIdx.x < 256) { const int r = threadIdx.x; sspart[(size_t)(trow + r) * 8 + u.pn] = (P[r * 4] + P[r * 4 + 1]) + (P[r * 4 + 2] + P[r * 4 + 3]); }
        xcd_barrier(bar);
        if (threadIdx.x < 256) { const int r = threadIdx.x; const f32x4 a = *(const f32x4*)(sspart + (size_t)(trow + r) * 8), b = *(const f32x4*)(sspart + (size_t)(trow + r) * 8 + 4);
            const float tot = ((a[0] + a[1]) + (a[2] + a[3])) + ((b[0] + b[1]) + (b[2] + b[3])); S[r] = rsqrtf(tot * (1.f / DM) + EPS); }
        __syncthreads();
        f32x4 gf[2][2];
#pragma unroll
        for (int bj = 0; bj < 2; ++bj)
#pragma unroll
            for (int n = 0; n < 2; ++n) gf[bj][n] = *(const f32x4*)(gfinal + col0 + bj * HALF + n * 16);
#pragma unroll
        for (int ai = 0; ai < 2; ++ai)
#pragma unroll
            for (int m = 0; m < 4; ++m) { const int r = ai * HALF + wr * 64 + m * 16 + fr; const float rs = S[r]; float* dst = out + (size_t)(trow + r) * DM + col0;
#pragma unroll
                for (int bj = 0; bj < 2; ++bj)
#pragma unroll
                    for (int n = 0; n < 2; ++n) *(f32x4*)(dst + bj * HALF + n * 16) = acc[ai][bj][m][n] * rs * gf[bj][n]; }
    }
};

template <class Epi>
__device__ __forceinline__ void gemm_phase(LAS unsigned char* lds, const Gemm g, const StaticOrder& S, const Epi& E) {
    int tid_ = threadIdx.x; asm volatile("" : "+v"(tid_));
    const int tid = tid_, wid = __builtin_amdgcn_readfirstlane(tid >> 6), lane = tid & 63, wr = wid >> 2, wc = wid & 3, fr = lane & 15, fq = lane >> 4;
    const int K = g.K, nt = K / BK, lda = g.lda;
    unsigned voffA[2], voffB[2];
#pragma unroll
    for (int i = 0; i < 2; ++i) { int R, C; stage_rc(tid * 16 + i * 8192, R, C); const int Rb = Epi::PERM ? ((R & ~31) + perm32(R & 31)) : R;
        voffA[i] = (unsigned)(R * lda + C) * 2u; voffB[i] = (unsigned)(Rb * K + C) * 2u; }
    const size_t kstep = (size_t)(BK * 2);
    const size_t hstepA = (size_t)HALF * lda * 2, hstepB = (size_t)HALF * K * 2;
    const size_t tstepA = 2 * hstepA, tstepB = 2 * hstepB;
    const unsigned ldsw = (unsigned)wid * 1024u;
    const int aoff = lds_byte(wr * 64 + fr, fq * 8), boff = lds_byte(wc * 32 + fr, fq * 8);
#define PG8_SA(b, h) (((b) * 2 + (h)) * HTB)
#define PG8_SB(b, h) ((4 + (b) * 2 + (h)) * HTB)
#define PG8_STAGE(bufoff, gbase, voff) do { _Pragma("unroll") for (int _i = 0; _i < 2; ++_i) \
        __builtin_amdgcn_global_load_lds((const unsigned*)((const char*)(gbase) + (voff)[_i]), (LAS unsigned*)(lds + (bufoff) + ldsw + _i * 8192), 16, 0, 0); } while (0)
#define PG8_LDA(dst, b, h) do { _Pragma("unroll") for (int m = 0; m < 4; ++m) _Pragma("unroll") for (int k = 0; k < 2; ++k) dst[m][k] = *(const LAS bf16x8*)(lds + PG8_SA(b, h) + aoff + m * 2048 + k * 1024); } while (0)
#define PG8_LDB(dst, b, h) do { _Pragma("unroll") for (int n = 0; n < 2; ++n) _Pragma("unroll") for (int k = 0; k < 2; ++k) dst[n][k] = *(const LAS bf16x8*)(lds + PG8_SB(b, h) + boff + n * 2048 + k * 1024); } while (0)
#define PG8_MMA(ai, bj, At, Bt) do { __builtin_amdgcn_s_setprio(1); _Pragma("unroll") for (int m = 0; m < 4; ++m) _Pragma("unroll") for (int n = 0; n < 2; ++n) _Pragma("unroll") for (int k = 0; k < 2; ++k) \
        acc[ai][bj][m][n] = __builtin_amdgcn_mfma_f32_16x16x32_bf16(Bt[n][k], At[m][k], acc[ai][bj][m][n], 0, 0, 0); __builtin_amdgcn_s_setprio(0); } while (0)
#define PG8_WAIT_V(n) asm volatile("s_waitcnt vmcnt(" #n ")" ::: "memory")
#define PG8_WAIT_L(n) asm volatile("s_waitcnt lgkmcnt(" #n ")" ::: "memory")
#define PG8_BAR __builtin_amdgcn_s_barrier()
#define PG8_SCHED __builtin_amdgcn_sched_barrier(0)
    Unit cur, nxt; int ui = 0;
    if (!S.next(0, cur)) return;
    f32x4 acc[2][2][4][2];
#pragma unroll
    for (int a = 0; a < 2; ++a)
#pragma unroll
        for (int b = 0; b < 2; ++b)
#pragma unroll
            for (int m = 0; m < 4; ++m)
#pragma unroll
                for (int n = 0; n < 2; ++n) acc[a][b][m][n] = (f32x4){0.f, 0.f, 0.f, 0.f};
    bf16x8 At[4][2], B0[2][2], B1[2][2];
    const char* cA = (const char*)g.A + (size_t)cur.pm * tstepA; const char* cB = (const char*)g.Bt + (size_t)cur.pn * tstepB;
    PG8_STAGE(PG8_SB(0, 0), cB, voffB); PG8_STAGE(PG8_SA(0, 0), cA, voffA); PG8_STAGE(PG8_SB(0, 1), cB + hstepB, voffB); PG8_STAGE(PG8_SA(0, 1), cA + hstepA, voffA);
    if (wr == 1) PG8_BAR;
    PG8_WAIT_V(4); PG8_BAR;
    PG8_STAGE(PG8_SB(1, 0), cB + kstep, voffB); PG8_STAGE(PG8_SA(1, 0), cA + kstep, voffA); PG8_STAGE(PG8_SB(1, 1), cB + hstepB + kstep, voffB);
    PG8_WAIT_V(6); PG8_BAR;
    for (;;) {
        const bool has_next = S.next(ui + 1, nxt);
        const char* nA = has_next ? (const char*)g.A + (size_t)nxt.pm * tstepA : cA; const char* nB = has_next ? (const char*)g.Bt + (size_t)nxt.pn * tstepB : cB;
        for (int t = 0; t < nt; t += 2) {
            const bool last = (t == nt - 2);
            const char* a1 = cA + (size_t)(t + 1) * kstep;
            const char* a2 = last ? nA : cA + (size_t)(t + 2) * kstep; const char* b2 = last ? nB : cB + (size_t)(t + 2) * kstep;
            const char* a3 = a2 + kstep; const char* b3 = b2 + kstep;
            PG8_LDB(B0, 0, 0); PG8_SCHED; PG8_LDA(At, 0, 0); PG8_STAGE(PG8_SA(1, 1), a1 + hstepA, voffA);
            PG8_WAIT_L(8); PG8_BAR; PG8_WAIT_L(0); PG8_MMA(0, 0, At, B0); PG8_BAR; PG8_SCHED;
            PG8_LDB(B1, 0, 1); PG8_STAGE(PG8_SB(0, 0), b2, voffB);
            PG8_BAR; PG8_WAIT_L(0); PG8_MMA(0, 1, At, B1); PG8_BAR;
            PG8_LDA(At, 0, 1); PG8_STAGE(PG8_SA(0, 0), a2, voffA);
            PG8_BAR; PG8_WAIT_L(0); PG8_MMA(1, 0, At, B0); PG8_BAR; PG8_SCHED;
            PG8_STAGE(PG8_SB(0, 1), b2 + hstepB, voffB);
            PG8_WAIT_V(6); PG8_BAR; PG8_MMA(1, 1, At, B1); PG8_BAR;
            PG8_LDB(B0, 1, 0); PG8_SCHED; PG8_LDA(At, 1, 0); PG8_STAGE(PG8_SA(0, 1), a2 + hstepA, voffA);
            PG8_WAIT_L(8); PG8_BAR; PG8_WAIT_L(0); PG8_MMA(0, 0, At, B0); PG8_BAR; PG8_SCHED;
            PG8_LDB(B1, 1, 1); PG8_STAGE(PG8_SB(1, 0), b3, voffB);
            PG8_BAR; PG8_WAIT_L(0); PG8_MMA(0, 1, At, B1); PG8_BAR;
            PG8_LDA(At, 1, 1); PG8_STAGE(PG8_SA(1, 0), a3, voffA);
            PG8_BAR; PG8_WAIT_L(0); PG8_MMA(1, 0, At, B0); PG8_BAR; PG8_SCHED;
            PG8_STAGE(PG8_SB(1, 1), b3 + hstepB, voffB);
            PG8_WAIT_V(6); PG8_BAR; PG8_MMA(1, 1, At, B1); PG8_BAR;
        }
        if constexpr (!Epi::AFTER_DRAIN) E(acc, cur, wr, wc, fr, fq);
        if (!has_next) break;
#pragma unroll
        for (int a = 0; a < 2; ++a)
#pragma unroll
            for (int b = 0; b < 2; ++b)
#pragma unroll
                for (int m = 0; m < 4; ++m)
#pragma unroll
                    for (int n = 0; n < 2; ++n) acc[a][b][m][n] = (f32x4){0.f, 0.f, 0.f, 0.f};
        cur = nxt; cA = nA; cB = nB; ++ui;
    }
    PG8_WAIT_V(0);
    if (wr == 0) PG8_BAR;
    PG8_BAR;
    if constexpr (Epi::AFTER_DRAIN) E.fused(acc, cur, wr, wc, fr, fq, lds);
#undef PG8_SA
#undef PG8_SB
#undef PG8_STAGE
#undef PG8_LDA
#undef PG8_LDB
#undef PG8_MMA
#undef PG8_WAIT_V
#undef PG8_WAIT_L
#undef PG8_BAR
#undef PG8_SCHED
}
}


#ifndef ATT_SDEPTH
#define ATT_SDEPTH 2
#endif
namespace att {
constexpr int SHM_V = 16384, SHM_K = 16384, SHM_KR = 8192;
constexpr int OFF_V = 0, OFF_K = 49152, OFF_KR = 81920, OFF_WS = 98304, OFF_BL = 100352, OFF_QR = 103424, ATT_LDS_END = 136192;
constexpr float SCALE_A = 0.088388347648318440f;
constexpr float SCALE_B = 0.072168783648703220f;
constexpr float THR = 8.f;
#define KSWZ(row, colB) ((row) * 256 + ((colB) ^ (((row) & 15) << 4)))
#define KRSWZ(row, colB) ((row) * 128 + ((colB) ^ ((((row) >> 1) & 7) << 4)))
#define SBAR() __builtin_amdgcn_sched_barrier(0)
__device__ __forceinline__ int crow(int r, int hi) { return (r & 3) + 8 * (r >> 2) + 4 * hi; }
__device__ __forceinline__ bf16x8 ld8(const bf16_t* p) { return *reinterpret_cast<const bf16x8*>(p); }

template <int MODE>
__device__ __forceinline__ void partialSM(f32x16& p0, f32x16& p1, float& m_reg, float& mn, float& alpha, const float* bl, int idx0) {
    if constexpr (MODE == 1) {
        constexpr float C = SCALE_B * LOG2E;
        float pmax = p0[0];
#pragma unroll
        for (int r = 1; r < 16; ++r) pmax = fmaxf(pmax, p0[r]);
#pragma unroll
        for (int r = 0; r < 16; ++r) pmax = fmaxf(pmax, p1[r]);
        { auto rr = __builtin_amdgcn_permlane32_swap(__float_as_uint(pmax), __float_as_uint(pmax), false, false);
          pmax = fmaxf(__uint_as_float(rr[0]), __uint_as_float(rr[1])); }
        if (__builtin_expect(__all(pmax - m_reg <= THR / SCALE_B), 1)) { mn = m_reg; alpha = 1.f; }
        else { mn = fmaxf(m_reg, pmax); alpha = __builtin_amdgcn_exp2f((m_reg - mn) * C); m_reg = mn; }
        const float mnC = -mn * C;
#pragma unroll
        for (int r = 0; r < 16; ++r) p0[r] = fmaf(p0[r], C, mnC);
#pragma unroll
        for (int r = 0; r < 16; ++r) p1[r] = fmaf(p1[r], C, mnC);
#pragma unroll
        for (int r = 0; r < 16; ++r) p0[r] = __builtin_amdgcn_exp2f(p0[r]);
    } else {
        constexpr float C = SCALE_A * LOG2E;
#pragma unroll
        for (int r4 = 0; r4 < 4; ++r4) {
#pragma unroll
            for (int e = 0; e < 4; ++e) { const int r = r4 * 4 + e, off = e + 8 * r4; p0[r] = fmaf(p0[r], C, bl[idx0 + off]); p1[r] = fmaf(p1[r], C, bl[idx0 + 32 + off]); }
            asm volatile("" ::: "memory");
        }
        float pmax = p0[0];
#pragma unroll
        for (int r = 1; r < 16; ++r) pmax = fmaxf(pmax, p0[r]);
#pragma unroll
        for (int r = 0; r < 16; ++r) pmax = fmaxf(pmax, p1[r]);
        { auto rr = __builtin_amdgcn_permlane32_swap(__float_as_uint(pmax), __float_as_uint(pmax), false, false);
          pmax = fmaxf(__uint_as_float(rr[0]), __uint_as_float(rr[1])); }
        if (__builtin_expect(__all(pmax - m_reg <= THR * LOG2E), 1)) { mn = m_reg; alpha = 1.f; }
        else { mn = fmaxf(m_reg, pmax); alpha = __builtin_amdgcn_exp2f(m_reg - mn); m_reg = mn; }
#pragma unroll
        for (int r = 0; r < 16; ++r) p0[r] = __builtin_amdgcn_exp2f(p0[r] - mn);
#pragma unroll
        for (int r = 0; r < 16; ++r) p1[r] = p1[r] - mn;
    }
}
__device__ __forceinline__ void finishSM(f32x16& p0, f32x16& p1, float alpha, float& l_reg, bf16x8& pa0, bf16x8& pa1, bf16x8& pa2, bf16x8& pa3) {
#pragma unroll
    for (int r = 0; r < 16; ++r) p1[r] = __builtin_amdgcn_exp2f(p1[r]);
    float ps = 0;
#pragma unroll
    for (int r = 0; r < 16; ++r) ps += p0[r];
#pragma unroll
    for (int r = 0; r < 16; ++r) ps += p1[r];
    { auto rr = __builtin_amdgcn_permlane32_swap(__float_as_uint(ps), __float_as_uint(ps), false, false);
      ps = __uint_as_float(rr[0]) + __uint_as_float(rr[1]); }
    l_reg = l_reg * alpha + ps;
#define PK4(P, BASE, OUT) do { unsigned a0 = cvt_pk_bf16(P[BASE + 0], P[BASE + 1]), a1 = cvt_pk_bf16(P[BASE + 2], P[BASE + 3]);   \
    unsigned b0 = cvt_pk_bf16(P[BASE + 4], P[BASE + 5]), b1 = cvt_pk_bf16(P[BASE + 6], P[BASE + 7]);                              \
    auto r0 = __builtin_amdgcn_permlane32_swap(a0, b0, false, false); auto r1 = __builtin_amdgcn_permlane32_swap(a1, b1, false, false); \
    u32x4 w = {r0[0], r1[0], r0[1], r1[1]}; OUT = *reinterpret_cast<bf16x8*>(&w); } while (0)
    PK4(p0, 0, pa0); PK4(p0, 8, pa1); PK4(p1, 0, pa2); PK4(p1, 8, pa3);
#undef PK4
}
__device__ __forceinline__ void finishSM_unused_nv(f32x16& p0, f32x16& p1, float alpha, float& l_reg, bf16x8& pa0, bf16x8& pa1, bf16x8& pa2, bf16x8& pa3) {
#pragma unroll
    for (int r = 0; r < 16; ++r) p1[r] = __builtin_amdgcn_exp2f(p1[r]);
    float ps = 0;
#pragma unroll
    for (int r = 0; r < 16; ++r) ps += p0[r];
#pragma unroll
    for (int r = 0; r < 16; ++r) ps += p1[r];
    { auto rr = __builtin_amdgcn_permlane32_swap(__float_as_uint(ps), __float_as_uint(ps), false, false);
      ps = __uint_as_float(rr[0]) + __uint_as_float(rr[1]); }
    l_reg = l_reg * alpha + ps;
#define PK4N(P, BASE, OUT) do { unsigned a0 = cvt_pk_nv(P[BASE + 0], P[BASE + 1]), a1 = cvt_pk_nv(P[BASE + 2], P[BASE + 3]);   \
    unsigned b0 = cvt_pk_nv(P[BASE + 4], P[BASE + 5]), b1 = cvt_pk_nv(P[BASE + 6], P[BASE + 7]);                              \
    auto r0 = __builtin_amdgcn_permlane32_swap(a0, b0, false, false); auto r1 = __builtin_amdgcn_permlane32_swap(a1, b1, false, false); \
    u32x4 w = {r0[0], r1[0], r0[1], r1[1]}; OUT = *reinterpret_cast<bf16x8*>(&w); } while (0)
    PK4N(p0, 0, pa0); PK4N(p0, 8, pa1); PK4N(p1, 0, pa2); PK4N(p1, 8, pa3);
#undef PK4N
}
template <int MODE>
__device__ __forceinline__ void qkt(f32x16& p0, f32x16& p1, const char* Ks, const char* Krs, const bf16x8* qr, const char* QRw, int qsw, int r32, int hi) {
    p0 = f32x16{}; p1 = f32x16{};
#pragma unroll
    for (int d0 = 0; d0 < 8; ++d0) { const int cb = (d0 * 16 + hi * 8) * 2;
        bf16x8 b0 = *reinterpret_cast<const bf16x8*>(Ks + KSWZ(r32, cb));
        bf16x8 b1 = *reinterpret_cast<const bf16x8*>(Ks + KSWZ(32 + r32, cb));
        p0 = __builtin_amdgcn_mfma_f32_32x32x16_bf16(b0, qr[d0], p0, 0, 0, 0);
        p1 = __builtin_amdgcn_mfma_f32_32x32x16_bf16(b1, qr[d0], p1, 0, 0, 0); }
    if constexpr (MODE == 1) {
#pragma unroll
        for (int d0 = 0; d0 < 4; ++d0) { const int cb = (d0 * 16 + hi * 8) * 2;
            bf16x8 b0 = *reinterpret_cast<const bf16x8*>(Krs + KRSWZ(r32, cb));
            bf16x8 b1 = *reinterpret_cast<const bf16x8*>(Krs + KRSWZ(32 + r32, cb));
            p0 = __builtin_amdgcn_mfma_f32_32x32x16_bf16(b0, qr[8 + d0], p0, 0, 0, 0);
            p1 = __builtin_amdgcn_mfma_f32_32x32x16_bf16(b1, qr[8 + d0], p1, 0, 0, 0); }
    }
}
__device__ __forceinline__ int v_st(int k, int c) { const int kk = (k & ~0xC) | ((k & 4) << 1) | ((k & 8) >> 1); return ((kk >> 3) * 4 + (c >> 5)) * 512 + ((kk & 7) * 32 + (c & 31)) * 2; }
__device__ __forceinline__ int v_rd_base(int lane) { return ((lane & 3) << 3) | (((lane >> 2) & 3) << 6) | (((lane >> 4) & 1) << 5) | (((lane >> 5) & 1) << 8); }
constexpr int v_rd_off(int d0, int ks, int half) { return d0 * 512 + ks * 4096 + half * 2048; }
template <int OFF> __device__ __forceinline__ s16x4 tr_read(int vb) {
    s16x4 r; asm volatile("ds_read_b64_tr_b16 %0, %1 offset:%2" : "=&v"(r) : "v"(vb), "i"(OFF) : "memory"); return r;
}
template <int D0> __device__ __forceinline__ void pv_one(f32x16& od, int vb, bf16x8 pa0, bf16x8 pa1, bf16x8 pa2, bf16x8 pa3) {
    const s16x4 l0 = tr_read<v_rd_off(D0, 0, 0)>(vb), h0 = tr_read<v_rd_off(D0, 0, 1)>(vb), l1 = tr_read<v_rd_off(D0, 1, 0)>(vb), h1 = tr_read<v_rd_off(D0, 1, 1)>(vb);
    const s16x4 l2 = tr_read<v_rd_off(D0, 2, 0)>(vb), h2 = tr_read<v_rd_off(D0, 2, 1)>(vb), l3 = tr_read<v_rd_off(D0, 3, 0)>(vb), h3 = tr_read<v_rd_off(D0, 3, 1)>(vb);
    asm volatile("s_waitcnt lgkmcnt(0)" ::: "memory"); SBAR();
#define PK(L, H) (bf16x8){L[0], L[1], L[2], L[3], H[0], H[1], H[2], H[3]}
    od = __builtin_amdgcn_mfma_f32_32x32x16_bf16(pa0, PK(l0, h0), od, 0, 0, 0);
    od = __builtin_amdgcn_mfma_f32_32x32x16_bf16(pa1, PK(l1, h1), od, 0, 0, 0);
    od = __builtin_amdgcn_mfma_f32_32x32x16_bf16(pa2, PK(l2, h2), od, 0, 0, 0);
    od = __builtin_amdgcn_mfma_f32_32x32x16_bf16(pa3, PK(l3, h3), od, 0, 0, 0);
#undef PK
}
__device__ __forceinline__ void pv_d0(f32x16* o, int vb, bf16x8 pa0, bf16x8 pa1, bf16x8 pa2, bf16x8 pa3) {
    pv_one<0>(o[0], vb, pa0, pa1, pa2, pa3); pv_one<1>(o[1], vb, pa0, pa1, pa2, pa3); pv_one<2>(o[2], vb, pa0, pa1, pa2, pa3); pv_one<3>(o[3], vb, pa0, pa1, pa2, pa3);
}

template <int MODE>
__device__ __forceinline__ void qk_half(f32x16& p, const char* Ks, const char* Krs, int rowoff, const bf16x8* qr, const char* QRw, int qsw, int r32, int hi) {
    p = f32x16{};
#pragma unroll
    for (int d0 = 0; d0 < 8; ++d0) { const int cb = (d0 * 16 + hi * 8) * 2;
        const bf16x8 b = *reinterpret_cast<const bf16x8*>(Ks + KSWZ(rowoff + r32, cb));
        p = __builtin_amdgcn_mfma_f32_32x32x16_bf16(b, qr[d0], p, 0, 0, 0); }
    if constexpr (MODE == 1) {
#pragma unroll
        for (int d0 = 0; d0 < 4; ++d0) { const int cb = (d0 * 16 + hi * 8) * 2;
            const bf16x8 b = *reinterpret_cast<const bf16x8*>(Krs + KRSWZ(rowoff + r32, cb));
            p = __builtin_amdgcn_mfma_f32_32x32x16_bf16(b, qr[8 + d0], p, 0, 0, 0); }
#ifdef XTRA_MFMA
        bf16x8 qz = {0, 0, 0, 0, 0, 0, 0, 0}; asm volatile("" : "+v"(qz));
#pragma unroll
        for (int e = 0; e < XTRA_MFMA; ++e) p = __builtin_amdgcn_mfma_f32_32x32x16_bf16(qr[e & 7], qz, p, 0, 0, 0);
#endif
    }
}
template <int MODE>
__device__ __forceinline__ void half_max(f32x16& p, float& m_reg, float& mn, float& alpha, const float* bl, int idx) {
    if constexpr (MODE == 0) {
        constexpr float C = SCALE_A * LOG2E;
#pragma unroll
        for (int r4 = 0; r4 < 4; ++r4) {
#pragma unroll
            for (int e = 0; e < 4; ++e) { const int r = r4 * 4 + e, off = e + 8 * r4; p[r] = fmaf(p[r], C, bl[idx + off]); }
        }
    }
    float pmax = fmaxf(p[0], p[1]);
#pragma unroll
    for (int r = 2; r < 16; ++r) pmax = fmaxf(pmax, p[r]);
    { auto rr = __builtin_amdgcn_permlane32_swap(__float_as_uint(pmax), __float_as_uint(pmax), false, false);
      pmax = fmaxf(__uint_as_float(rr[0]), __uint_as_float(rr[1])); }
    if constexpr (MODE == 1) {
        constexpr float C = SCALE_B * LOG2E;
        if (__builtin_expect(__all(pmax - m_reg <= THR / SCALE_B), 1)) { mn = m_reg; alpha = 1.f; }
        else { mn = fmaxf(m_reg, pmax); alpha = __builtin_amdgcn_exp2f((m_reg - mn) * C); m_reg = mn; }
    } else {
        if (__builtin_expect(__all(pmax - m_reg <= THR * LOG2E), 1)) { mn = m_reg; alpha = 1.f; }
        else { mn = fmaxf(m_reg, pmax); alpha = __builtin_amdgcn_exp2f(m_reg - mn); m_reg = mn; }
    }
}
template <int MODE>
__device__ __forceinline__ void half_exp(f32x16& p, float mn, float alpha, float& l_reg, bf16x8& paA, bf16x8& paB) {
    if constexpr (MODE == 1) {
        constexpr float C = SCALE_B * LOG2E; const float mnC = -mn * C;
#pragma unroll
        for (int r = 0; r < 16; ++r) p[r] = __builtin_amdgcn_exp2f(fmaf(p[r], C, mnC));
    } else {
#pragma unroll
        for (int r = 0; r < 16; ++r) p[r] = __builtin_amdgcn_exp2f(p[r] - mn);
    }
    float ps = 0;
#pragma unroll
    for (int r = 0; r < 16; ++r) ps += p[r];
    { auto rr = __builtin_amdgcn_permlane32_swap(__float_as_uint(ps), __float_as_uint(ps), false, false);
      ps = __uint_as_float(rr[0]) + __uint_as_float(rr[1]); }
    l_reg = l_reg * alpha + ps;
#define PK4N(P, BASE, OUT) do { unsigned a0 = cvt_pk_nv(P[BASE + 0], P[BASE + 1]), a1 = cvt_pk_nv(P[BASE + 2], P[BASE + 3]);   \
    unsigned b0 = cvt_pk_nv(P[BASE + 4], P[BASE + 5]), b1 = cvt_pk_nv(P[BASE + 6], P[BASE + 7]);                              \
    auto r0 = __builtin_amdgcn_permlane32_swap(a0, b0, false, false); auto r1 = __builtin_amdgcn_permlane32_swap(a1, b1, false, false); \
    u32x4 w = {r0[0], r1[0], r0[1], r1[1]}; OUT = *reinterpret_cast<bf16x8*>(&w); } while (0)
    PK4N(p, 0, paA); PK4N(p, 8, paB);
#undef PK4N
}
template <int H>
__device__ __forceinline__ void pv_half(f32x16* o, unsigned vl, bf16x8 paA, bf16x8 paB) {
    typedef LAS s16x4* trp;
#define TRR(d0, ks, half) __builtin_amdgcn_ds_read_tr16_b64_v4i16((trp)(vl + (unsigned)v_rd_off(d0, ks, half)))
#define PKV(L, Hh) (bf16x8){L[0], L[1], L[2], L[3], Hh[0], Hh[1], Hh[2], Hh[3]}
#pragma unroll
    for (int d0 = 0; d0 < 4; ++d0) {
        const s16x4 lA = TRR(d0, 2 * H, 0), hA = TRR(d0, 2 * H, 1), lB = TRR(d0, 2 * H + 1, 0), hB = TRR(d0, 2 * H + 1, 1);
        o[d0] = __builtin_amdgcn_mfma_f32_32x32x16_bf16(paA, PKV(lA, hA), o[d0], 0, 0, 0);
        o[d0] = __builtin_amdgcn_mfma_f32_32x32x16_bf16(paB, PKV(lB, hB), o[d0], 0, 0, 0);
    }
#undef TRR
#undef PKV
}

template <int MODE>
__device__ __forceinline__ void pv_psm(f32x16* o, int vb, bf16x8 pa0, bf16x8 pa1, bf16x8 pa2, bf16x8 pa3,
                                       f32x16& p0, f32x16& p1, float& m_reg, float& mn, float& alpha, const float* bl, int idx0) {
    pv_one<0>(o[0], vb, pa0, pa1, pa2, pa3);
    if constexpr (MODE == 0) { constexpr float C = SCALE_A * LOG2E;
#pragma unroll
        for (int r = 0; r < 16; ++r) { const int off = (r & 3) + 8 * (r >> 2); p0[r] = fmaf(p0[r], C, bl[idx0 + off]); } }
    float pm0 = fmaxf(p0[0], p0[1]);
#pragma unroll
    for (int r = 2; r < 16; ++r) pm0 = fmaxf(pm0, p0[r]);
    pv_one<1>(o[1], vb, pa0, pa1, pa2, pa3);
    if constexpr (MODE == 0) { constexpr float C = SCALE_A * LOG2E;
#pragma unroll
        for (int r = 0; r < 16; ++r) { const int off = (r & 3) + 8 * (r >> 2); p1[r] = fmaf(p1[r], C, bl[idx0 + 32 + off]); } }
    float pmax = pm0;
#pragma unroll
    for (int r = 0; r < 16; ++r) pmax = fmaxf(pmax, p1[r]);
    { auto rr = __builtin_amdgcn_permlane32_swap(__float_as_uint(pmax), __float_as_uint(pmax), false, false);
      pmax = fmaxf(__uint_as_float(rr[0]), __uint_as_float(rr[1])); }
    if constexpr (MODE == 1) { constexpr float C = SCALE_B * LOG2E;
        if (__builtin_expect(__all(pmax - m_reg <= THR / SCALE_B), 1)) { mn = m_reg; alpha = 1.f; }
        else { mn = fmaxf(m_reg, pmax); alpha = __builtin_amdgcn_exp2f((m_reg - mn) * C); m_reg = mn; }
    } else {
        if (__builtin_expect(__all(pmax - m_reg <= THR * LOG2E), 1)) { mn = m_reg; alpha = 1.f; }
        else { mn = fmaxf(m_reg, pmax); alpha = __builtin_amdgcn_exp2f(m_reg - mn); m_reg = mn; }
    }
    pv_one<2>(o[2], vb, pa0, pa1, pa2, pa3);
    if constexpr (MODE == 1) { constexpr float C = SCALE_B * LOG2E; const float mnC = -mn * C;
#pragma unroll
        for (int r = 0; r < 16; ++r) p0[r] = fmaf(p0[r], C, mnC);
#pragma unroll
        for (int r = 0; r < 16; ++r) p1[r] = fmaf(p1[r], C, mnC);
    } else {
#pragma unroll
        for (int r = 0; r < 16; ++r) p0[r] = p0[r] - mn;
#pragma unroll
        for (int r = 0; r < 16; ++r) p1[r] = p1[r] - mn;
    }
    pv_one<3>(o[3], vb, pa0, pa1, pa2, pa3);
#pragma unroll
    for (int r = 0; r < 16; ++r) p0[r] = __builtin_amdgcn_exp2f(p0[r]);
}

template <int MODE>
__device__ __forceinline__ void attn_item(const bf16_t* __restrict__ Qb, const bf16_t* __restrict__ Qrb, const bf16_t* __restrict__ Kh, const bf16_t* __restrict__ Krh,
                                          const bf16_t* __restrict__ Vh, bf16_t* __restrict__ Ob, int NT, int relbase, float m_init, float l_init, char* lds) {
    constexpr int LDK = MODE ? 2048 : LDP;
    constexpr int SDEPTH = 1;
    int tid_ = threadIdx.x; asm volatile("" : "+v"(tid_));
    const int tid = tid_, wid = tid >> 6, lane = tid & 63, r32 = lane & 31, hi = lane >> 5;
    char* V_lds = lds + OFF_V; char* K_lds = lds + OFF_K; char* KR_lds = lds + OFF_KR;
    float* ws = (float*)(lds + OFF_WS) + wid * 64; float* li_l = ws; float* al_l = ws + 32;
    const float* bl = (const float*)(lds + OFF_BL);
    float m_reg = m_init, l_reg = l_init; f32x16 o[4] = {}; bf16x8 qr[MODE ? 12 : 8];
    const bf16_t* Qw = Qb + (long)(wid * 32 + r32) * LDP + hi * 8;
#pragma unroll
    for (int d0 = 0; d0 < 8; ++d0) qr[d0] = ld8(Qw + d0 * 16);
    char* QR_lds = lds + OFF_QR; const int qrow = wid * 32 + r32;
    const char* QRw = QR_lds + qrow * 128; const int qsw = ((qrow >> 1) & 7) << 4;
    if constexpr (MODE == 1) {
        const bf16_t* Qrw = Qrb + (long)(wid * 32 + r32) * LDP + hi * 8;
#pragma unroll
        for (int d0 = 0; d0 < 4; ++d0) qr[8 + d0] = ld8(Qrw + d0 * 16);
    }
    const int widu = __builtin_amdgcn_readfirstlane(tid >> 6);
    LAS unsigned char* l3 = (LAS unsigned char*)lds;
    const unsigned wbase = (unsigned)widu * 1024u;
    int offK, offV, offKR;
    { const int row = tid >> 4, cpos = tid & 15; offK = row * LDK + ((cpos ^ (row & 15)) * 8); }
    { const int kkhi = tid >> 7, chi = (tid >> 5) & 3, w = tid & 31, kk = kkhi * 8 + (w >> 2), k = (kk & ~0xC) | ((kk & 4) << 1) | ((kk & 8) >> 1); offV = k * LDK + chi * 32 + (w & 3) * 8; }
    { const int row = tid >> 3, cpos = tid & 7; offKR = row * LDP + ((cpos ^ ((row >> 1) & 7)) * 8); }
    const int vb0 = (int)(uintptr_t)V_lds + v_rd_base(lane);
    const int idxw = relbase - wid * 32 - r32 + 384 + 4 * hi;
#define GLDS(gptr, ldsoff) __builtin_amdgcn_global_load_lds((const unsigned*)(gptr), (LAS unsigned*)(l3 + (ldsoff)), 16, 0, 0)
#define TLOAD(kb, vb_, k0) do { int t_ = tid; asm volatile("" : "+v"(t_)); \
    const int rK_ = t_ >> 4, cK_ = t_ & 15; const int oK_ = rK_ * LDK + ((cK_ ^ (rK_ & 15)) * 8); \
    const int kkhi_ = t_ >> 7, chi_ = (t_ >> 5) & 3, w_ = t_ & 31, kk_ = kkhi_ * 8 + (w_ >> 2), k_ = (kk_ & ~0xC) | ((kk_ & 4) << 1) | ((kk_ & 8) >> 1); const int oV_ = k_ * LDK + chi_ * 32 + (w_ & 3) * 8; \
    const bf16_t* kg_ = Kh + (long)(k0) * LDK + oK_; const bf16_t* vg_ = Vh + (long)(k0) * LDK + oV_; \
    GLDS(kg_, OFF_K + (kb) * SHM_K + wbase); GLDS(kg_ + 32 * LDK, OFF_K + (kb) * SHM_K + wbase + 8192u); \
    GLDS(vg_, OFF_V + (vb_) * SHM_V + wbase); GLDS(vg_ + 32 * LDK, OFF_V + (vb_) * SHM_V + wbase + 8192u); \
    if constexpr (MODE == 1) { const int rR_ = t_ >> 3, cR_ = t_ & 7; const int oR_ = rR_ * LDP + ((cR_ ^ ((rR_ >> 1) & 7)) * 8); GLDS(Krh + (long)(k0) * LDP + oR_, OFF_KR + (kb) * SHM_KR + wbase); } } while (0)
#define RESC(a) do { if (__any((a) < 1.f)) { if (hi == 0) al_l[r32] = (a); asm volatile("s_waitcnt lgkmcnt(0)" ::: "memory"); \
    _Pragma("unroll") for (int d = 0; d < 4; ++d) _Pragma("unroll") for (int r = 0; r < 16; ++r) o[d][r] *= al_l[crow(r, hi)]; } } while (0)
    f32x16 pA0, pA1, pB0, pB1; float mnA, mnB, alA, alB; bf16x8 pa0, pa1, pa2, pa3;
    const unsigned vl0 = (unsigned)(uintptr_t)(l3 + OFF_V) + (unsigned)v_rd_base(lane);
#define QK2(P0, P1, kb) qkt<MODE>(P0, P1, K_lds + (kb) * SHM_K, KR_lds + (kb) * SHM_KR, qr, QRw, qsw, r32, hi)
#define PV2(vbuf) pv_d0(o, vb0 + (vbuf) * SHM_V, pa0, pa1, pa2, pa3)
#define TBAR() do { asm volatile("s_waitcnt vmcnt(0)" ::: "memory"); __syncthreads(); } while (0)
    int vprev = 0, vcur = 1, vnext = 2;
    TLOAD(0, 0, 0); asm volatile("s_waitcnt vmcnt(0)" ::: "memory"); __syncthreads();
    if (1 < NT) TLOAD(1, 1, 64);
    QK2(pA0, pA1, 0); partialSM<MODE>(pA0, pA1, m_reg, mnA, alA, bl, idxw);
    RESC(alA);
    TBAR();
    for (int j = 1; j + 1 < NT; j += 2) {
        if (j + 1 < NT) TLOAD(0, vnext, (j + 1) * 64);
        SBAR(); QK2(pB0, pB1, 1); finishSM(pA0, pA1, alA, l_reg, pa0, pa1, pa2, pa3); SBAR();
        pv_psm<MODE>(o, vb0 + vprev * SHM_V, pa0, pa1, pa2, pa3, pB0, pB1, m_reg, mnB, alB, bl, idxw + 64 * j);
        RESC(alB);
        TBAR();
        { const int t_ = vprev; vprev = vcur; vcur = vnext; vnext = t_; }
        if (j + 2 < NT) TLOAD(1, vnext, (j + 2) * 64);
        SBAR(); QK2(pA0, pA1, 0); finishSM(pB0, pB1, alB, l_reg, pa0, pa1, pa2, pa3); SBAR();
        pv_psm<MODE>(o, vb0 + vprev * SHM_V, pa0, pa1, pa2, pa3, pA0, pA1, m_reg, mnA, alA, bl, idxw + 64 * (j + 1));
        RESC(alA);
        TBAR();
        { const int t_ = vprev; vprev = vcur; vcur = vnext; vnext = t_; }
    }
    SBAR(); QK2(pB0, pB1, 1); finishSM(pA0, pA1, alA, l_reg, pa0, pa1, pa2, pa3); SBAR();
    pv_psm<MODE>(o, vb0 + vprev * SHM_V, pa0, pa1, pa2, pa3, pB0, pB1, m_reg, mnB, alB, bl, idxw + 64 * (NT - 1));
    RESC(alB);
    finishSM(pB0, pB1, alB, l_reg, pa0, pa1, pa2, pa3);
    PV2(vcur);
    __syncthreads();
#undef QK2
#undef PV2
#undef TBAR
    if (hi == 0) li_l[r32] = l_reg; asm volatile("s_waitcnt lgkmcnt(0)" ::: "memory");
    float rli[16];
#pragma unroll
    for (int r = 0; r < 16; ++r) rli[r] = __builtin_amdgcn_rcpf(li_l[crow(r, hi)]);
    __syncthreads();
    char* stg = lds + wid * 8704;
#pragma unroll
    for (int r = 0; r < 16; ++r) { const int orow = crow(r, hi);
#pragma unroll
        for (int d0 = 0; d0 < 4; ++d0) *(bf16_t*)(stg + orow * 272 + (d0 * 32 + r32) * 2) = f2bf(o[d0][r] * rli[r]); }
    asm volatile("s_waitcnt lgkmcnt(0)" ::: "memory");
    bf16_t* Ow = Ob + (long)(wid * 32 + (lane >> 4)) * LDP + (lane & 15) * 8;
    const char* srd = stg + (lane >> 4) * 272 + (lane & 15) * 16;
#pragma unroll
    for (int i = 0; i < 8; ++i) *(u32x4*)(Ow + (long)(i * 4) * LDP) = *(const u32x4*)(srd + i * 4 * 272);
#undef GLDS
#undef TLOAD
#undef RESC
}
}

__device__ __forceinline__ int win_dst_row(int n0) {
    if (n0 < 1024) return n0;
    if (n0 < 1536) return n0 + 1024;
    if (n0 < 2560) return n0 - 512;
    return n0;
}

__device__ __forceinline__ void phase0(const Params& p, unsigned char* lds_) {
    const int tid = threadIdx.x;
    bf16_t* wt_in = (bf16_t*)(p.ws + WS_WIN);
    for (int i = blockIdx.x * 512 + tid; i < 192 * DM * 2 / 16; i += gridDim.x * 512) ((u32x4*)(wt_in + (size_t)3648 * DM))[i] = (u32x4){0u, 0u, 0u, 0u};
    float* tile = (float*)lds_;
    constexpr int T_IN = 32 * 57, T_KVB = 8 * 32, T_O = 32 * 32, T_FF1 = 32 * 128, T_FF2 = 128 * 32, T_ALL = T_IN + T_KVB + T_O + T_FF1 + T_FF2;
    for (int t = blockIdx.x; t < T_ALL; t += gridDim.x) {
        const float* src; bf16_t* dst; int K, N, tt = t; bool isin = false;
        if (tt < T_IN) { src = p.w_in; dst = wt_in; K = 2048; N = 3648; isin = true; }
        else if ((tt -= T_IN) < T_KVB) { src = p.w_kv_b; dst = (bf16_t*)(p.ws + WS_WKVB); K = 512; N = 2048; }
        else if ((tt -= T_KVB) < T_O) { src = p.w_o; dst = (bf16_t*)(p.ws + WS_WO); K = 2048; N = 2048; }
        else if ((tt -= T_O) < T_FF1) { src = p.w_ff1; dst = (bf16_t*)(p.ws + WS_WFF1); K = 2048; N = 8192; }
        else { tt -= T_FF1; src = p.w_ff2; dst = (bf16_t*)(p.ws + WS_WFF2); K = 8192; N = 2048; }
        const int nkt = K / 64, kt = tt % nkt, nti = tt / nkt, k0 = kt * 64, n0 = nti * 64;
        const int d0 = isin ? win_dst_row(n0) : n0;
        { const int r = tid >> 4, c4 = tid & 15;
#pragma unroll
          for (int i = 0; i < 2; ++i) { const int k = r + 32 * i; const f32x4 v = *(const f32x4*)(src + (size_t)(k0 + k) * N + n0 + c4 * 4);
              tile[k * 65 + c4 * 4 + 0] = v[0]; tile[k * 65 + c4 * 4 + 1] = v[1]; tile[k * 65 + c4 * 4 + 2] = v[2]; tile[k * 65 + c4 * 4 + 3] = v[3]; } }
        __syncthreads();
        { const int n = tid >> 3, kc = tid & 7; float v[8];
#pragma unroll
          for (int j = 0; j < 8; ++j) v[j] = tile[(kc * 8 + j) * 65 + n];
          u32x4 w; w.x = cvt_pk_bf16(v[0], v[1]); w.y = cvt_pk_bf16(v[2], v[3]); w.z = cvt_pk_bf16(v[4], v[5]); w.w = cvt_pk_bf16(v[6], v[7]);
          *(u32x4*)(dst + (size_t)(d0 + n) * K + k0 + kc * 8) = w; }
        __syncthreads();
    }
    float* sl = (float*)lds_;
    float* red = sl + 9 * 2048;
    for (int i = tid; i < 9 * 2048; i += 512) { const float v = i < 8 * 2048 ? p.c_prompt[i] : p.c_sample[i - 8 * 2048]; sl[i] = v / (1.f + __expf(-v)); }
    __syncthreads();
    float* mod = (float*)(p.ws + WS_MOD);
    for (int cgp = blockIdx.x; cgp < 256; cgp += gridDim.x) {
        if (tid < 384) {
            const int cq = tid % 12, kg = tid / 12, j0 = cgp * 48 + cq * 4;
            f32x4 acc[9];
#pragma unroll
            for (int b = 0; b < 9; ++b) acc[b] = (f32x4){0.f, 0.f, 0.f, 0.f};
#pragma unroll 8
            for (int k = kg * 64; k < kg * 64 + 64; ++k) { const f32x4 w = *(const f32x4*)(p.w_ada + (size_t)k * MODW + j0);
#pragma unroll
                for (int b = 0; b < 9; ++b) acc[b] += sl[b * 2048 + k] * w; }
#pragma unroll
            for (int b = 0; b < 9; ++b)
#pragma unroll
                for (int e = 0; e < 4; ++e) red[(kg * 9 + b) * 48 + cq * 4 + e] = acc[b][e];
        }
        __syncthreads();
        for (int i = tid; i < 432; i += 512) { const int b = i / 48, j = i % 48; float s = p.b_ada[cgp * 48 + j];
            for (int kg = 0; kg < 32; ++kg) s += red[(kg * 9 + b) * 48 + j];
            mod[b * MODW + cgp * 48 + j] = s; }
        __syncthreads();
    }
}

template <int KIND>
__device__ __forceinline__ void rows_norm(const Params& p, bf16_t* dst) {
    const int wid = threadIdx.x >> 6, lane = threadIdx.x & 63;
    const float* mod = (const float*)(p.ws + WS_MOD);
    const float* g = KIND == 0 ? p.g_mix : (KIND == 1 ? p.g_mlp : p.g_final);
    for (int grp = blockIdx.x * 8 + wid; grp < NTOK / 16; grp += gridDim.x * 8) {
        const int rbase = grp * 16; const int batch = rbase < NPROMPT ? (rbase >> 11) : 8;
        const float* mb = mod + (size_t)batch * MODW + (KIND == 0 ? 0 : 3 * DM);
        f32x4 mv[8], sv[8];
#pragma unroll
        for (int i = 0; i < 8; ++i) { const int col = i * 256 + lane * 4; mv[i] = *(const f32x4*)(g + col);
            if (KIND < 2) { mv[i] = mv[i] * (1.f + *(const f32x4*)(mb + DM + col)); sv[i] = *(const f32x4*)(mb + col); } else sv[i] = (f32x4){0.f, 0.f, 0.f, 0.f}; }
#pragma unroll 1
        for (int r2 = 0; r2 < 8; ++r2) {
            f32x4 v[2][8];
#pragma unroll
            for (int h = 0; h < 2; ++h) { const int row = rbase + 2 * r2 + h;
                const float* src = KIND == 0 ? (row < NPROMPT ? p.x_prompt + (size_t)row * DM : p.x_sample + (size_t)(row - NPROMPT) * DM) : p.out + (size_t)row * DM;
#pragma unroll
                for (int i = 0; i < 8; ++i) v[h][i] = *(const f32x4*)(src + i * 256 + lane * 4); }
#pragma unroll
            for (int h = 0; h < 2; ++h) { const int row = rbase + 2 * r2 + h;
                float ss = 0.f;
#pragma unroll
                for (int i = 0; i < 8; ++i) ss += v[h][i][0] * v[h][i][0] + v[h][i][1] * v[h][i][1] + v[h][i][2] * v[h][i][2] + v[h][i][3] * v[h][i][3];
                ss = wave_sum(ss);
                const float rstd = rsqrtf(ss * (1.f / DM) + EPS);
#pragma unroll
                for (int i = 0; i < 8; ++i) { const int col = i * 256 + lane * 4; const f32x4 y = v[h][i] * rstd * mv[i] + sv[i];
                    if (KIND < 2) { u32x2 w; w.x = cvt_pk_bf16(y[0], y[1]); w.y = cvt_pk_bf16(y[2], y[3]); *(u32x2*)(dst + (size_t)row * DM + col) = w; }
                    else *(f32x4*)(p.out + (size_t)row * DM + col) = y; } }
        }
    }
}

__device__ __forceinline__ void phase1_side(const Params& p, unsigned char* lds_) {
    const int wid = threadIdx.x >> 6, lane = threadIdx.x & 63;
    float* ss2 = (float*)(p.ws + WS_SS2);
    for (int i = blockIdx.x * 512 + threadIdx.x; i < NTOK; i += gridDim.x * 512) ss2[i] = 0.f;
    const float* mod = (const float*)(p.ws + WS_MOD); const bf16_t* w1t = (const bf16_t*)(p.ws + WS_WFF1); float* b2 = (float*)(p.ws + WS_B2);
    float* sl = (float*)lds_;
    for (int i = threadIdx.x; i < 9 * DM / 4; i += 512) { const int b = i / (DM / 4), k4 = i % (DM / 4); *(f32x4*)(sl + b * DM + k4 * 4) = *(const f32x4*)(mod + (size_t)b * MODW + 3 * DM + k4 * 4); }
    __syncthreads();
    for (int n = blockIdx.x * 8 + wid; n < DFF; n += gridDim.x * 8) {
        float w[32];
#pragma unroll
        for (int i = 0; i < 4; ++i) { const u32x4 v = *(const u32x4*)(w1t + (size_t)n * DM + i * 512 + lane * 8);
#pragma unroll
            for (int j = 0; j < 4; ++j) { w[i * 8 + 2 * j] = __uint_as_float(v[j] << 16); w[i * 8 + 2 * j + 1] = __uint_as_float(v[j] & 0xffff0000u); } }
        float acc[9];
#pragma unroll
        for (int b = 0; b < 9; ++b) { float a = 0.f;
#pragma unroll
            for (int i = 0; i < 4; ++i) { const f32x4 s0 = *(const f32x4*)(sl + b * DM + i * 512 + lane * 8), s1 = *(const f32x4*)(sl + b * DM + i * 512 + lane * 8 + 4);
                a += s0[0] * w[i * 8] + s0[1] * w[i * 8 + 1] + s0[2] * w[i * 8 + 2] + s0[3] * w[i * 8 + 3] + s1[0] * w[i * 8 + 4] + s1[1] * w[i * 8 + 5] + s1[2] * w[i * 8 + 6] + s1[3] * w[i * 8 + 7]; }
            acc[b] = a; asm volatile("" ::: "memory"); }
#pragma unroll
        for (int b = 0; b < 9; ++b) acc[b] = wave_sum(acc[b]);
        if (lane == 0) {
#pragma unroll
            for (int b = 0; b < 9; ++b) b2[(size_t)b * DFF + n] = acc[b]; }
    }
    __syncthreads();
}

__device__ __forceinline__ void phase_rope(const Params& p) {
    const int wid = threadIdx.x >> 6, lane = threadIdx.x & 63, i32 = lane & 31;
    bf16_t* proj = (bf16_t*)(p.ws + WS_PROJ);
    const double inv = exp2(-(double)i32 * (13.287712379549449 / 32.0));
    f32x4 g0 = *(const f32x4*)(p.g_kv + lane * 8), g1 = *(const f32x4*)(p.g_kv + lane * 8 + 4);
    const int stride = gridDim.x * 8;
    for (int t0 = blockIdx.x * 8 + wid; t0 < NTOK; t0 += 2 * stride) {
        float qa[2][4], qb[2][4], ka[2], kb[2]; u32x4 cv[2];
#pragma unroll
        for (int h = 0; h < 2; ++h) { const int t = t0 + h * stride; if (t < NTOK) { const bf16_t* row = proj + (size_t)t * LDP;
#pragma unroll
            for (int j = 0; j < 4; ++j) { const bf16_t* q = row + C_QR + (2 * j + (lane >> 5)) * 64 + i32; qa[h][j] = bf2f(q[0]); qb[h][j] = bf2f(q[32]); }
            { const bf16_t* q = row + C_KR + i32; ka[h] = bf2f(q[0]); kb[h] = bf2f(q[32]); }
            cv[h] = *(const u32x4*)(row + C_CKV + lane * 8); } }
#pragma unroll
        for (int h = 0; h < 2; ++h) { const int t = t0 + h * stride; if (t < NTOK) {
            const int pos = t < NPROMPT ? (t & (SEQP - 1)) : t - NPROMPT;
            bf16_t* row = proj + (size_t)t * LDP;
            double a = (double)pos * inv; a -= 6.283185307179586 * rint(a * 0.15915494309189535);
            const float af = (float)a, sn = sinf(af), cs = cosf(af);
#pragma unroll
            for (int j = 0; j < 4; ++j) { bf16_t* q = row + C_QR + (2 * j + (lane >> 5)) * 64 + i32; const float x1 = qa[h][j], x2 = qb[h][j];
                q[0] = f2bf(x1 * cs - x2 * sn); q[32] = f2bf(x1 * sn + x2 * cs); }
            if (lane < 32) { bf16_t* q = row + C_KR + i32; const float x1 = ka[h], x2 = kb[h]; q[0] = f2bf(x1 * cs - x2 * sn); q[32] = f2bf(x1 * sn + x2 * cs); }
            float x[8];
#pragma unroll
            for (int j = 0; j < 4; ++j) { x[2 * j] = __uint_as_float(cv[h][j] << 16); x[2 * j + 1] = __uint_as_float(cv[h][j] & 0xffff0000u); }
            float ss = 0.f;
#pragma unroll
            for (int j = 0; j < 8; ++j) ss += x[j] * x[j];
            ss = wave_sum(ss);
            const float rstd = rsqrtf(ss * (1.f / 512.f) + EPS);
            u32x4 w; w.x = cvt_pk_bf16(x[0] * rstd * g0[0], x[1] * rstd * g0[1]); w.y = cvt_pk_bf16(x[2] * rstd * g0[2], x[3] * rstd * g0[3]);
            w.z = cvt_pk_bf16(x[4] * rstd * g1[0], x[5] * rstd * g1[1]); w.w = cvt_pk_bf16(x[6] * rstd * g1[2], x[7] * rstd * g1[3]);
            *(u32x4*)(row + C_CKV + lane * 8) = w; } }
    }
}

__device__ __forceinline__ int t5_bucket(int rel) {
    const int n = rel < 0 ? -rel : rel; int b;
    if (n < 8) b = n; else if (n < 12) b = 8; else if (n < 16) b = 9; else if (n < 23) b = 10; else if (n < 32) b = 11; else if (n < 46) b = 12; else if (n < 64) b = 13; else if (n < 91) b = 14; else b = 15;
    return b + (rel > 0 ? 16 : 0);
}

#ifndef NB_ITEMS
#define NB_ITEMS 1024
#endif
#ifndef NA_ITEMS
#define NA_ITEMS 1024
#endif
__device__ __forceinline__ void phase_attn(const Params& p, char* lds, int vbid) {
    bf16_t* proj = (bf16_t*)(p.ws + WS_PROJ); const bf16_t* kvb = (const bf16_t*)(p.ws + WS_R2);
    const int G = gridDim.x, bid = vbid;
#ifdef ATT_TWICE
    for (int rep = 0; rep < 2; ++rep) {
    bf16_t* oproj = rep == 0 ? (bf16_t*)p.out : proj;
#else
    bf16_t* oproj = proj;
    {
#endif
    for (int it = bid; it < NB_ITEMS; it += G) {
        const int h = it & 7; int row0, kbase, S;
        if (it < 512) { const int qb = it >> 3; row0 = NPROMPT + qb * 256; kbase = NPROMPT; S = SEQS; }
        else { const int r = (it - 512) >> 3; const int seq = r >> 3, qb = r & 7; row0 = seq * SEQP + qb * 256; kbase = seq * SEQP; S = SEQP; }
        __syncthreads();
        bf16_t* Qb = proj + (size_t)row0 * LDP + C_QN + h * 128;
        att::attn_item<1>(Qb, proj + (size_t)row0 * LDP + C_QR + h * 64, kvb + (size_t)kbase * 2048 + h * 256, proj + (size_t)kbase * LDP + C_KR,
                          kvb + (size_t)kbase * 2048 + h * 256 + 128, oproj + (size_t)row0 * LDP + C_QN + h * 128, S / 64, 0, -1e30f, 0.f, lds);
    }
    float* bl = (float*)(lds + att::OFF_BL);
    for (int it = bid; it < NA_ITEMS; it += G) {
        const int h = it & 7, kvh = h >> 2, row0 = (it >> 3) * 256;
        const int seq0 = row0 < NPROMPT ? (row0 & ~(SEQP - 1)) : NPROMPT, S = row0 < NPROMPT ? SEQP : SEQS, pos0 = row0 - seq0;
        const int kf = pos0 - 128 < 0 ? 0 : pos0 - 128, kl = pos0 + 384 > S ? S : pos0 + 384;
        __syncthreads();
        for (int i = threadIdx.x; i < 768; i += 512) { const int rel = i - 384; bl[i] = (rel >= -128 && rel <= 128) ? p.rel_bias[t5_bucket(rel) * 8 + h] * LOG2E : -1e30f; }
        bf16_t* Qb = proj + (size_t)row0 * LDP + C_QA + h * 128;
        att::attn_item<0>(Qb, nullptr, proj + (size_t)(seq0 + kf) * LDP + C_KA + kvh * 128, nullptr, proj + (size_t)(seq0 + kf) * LDP + C_VA + kvh * 128, oproj + (size_t)row0 * LDP + C_QA + h * 128,
                          (kl - kf) / 64, kf - pos0, p.sink[h] * LOG2E, 1.f, lds);
    }
    }
}

__global__ void __launch_bounds__(512) fwd_mega(Params p) {
    extern __shared__ __attribute__((aligned(16))) unsigned char lds[];
    cg::grid_group grid = cg::this_grid();
    const int lo = p.ph_lo, hi = p.ph_hi;
#ifndef PH_MASK
#define PH_MASK 0x1ffff
#endif
#define IN(k) (((PH_MASK >> (k)) & 1) && lo <= (k) && (k) < hi)
#define SEAM(k) do { if (IN(k) && IN((k) + 1)) { if (p.coop == 2) grid.sync(); else xcd_barrier(xbar); } } while (0)
    { volatile LAS unsigned* st = (volatile LAS unsigned*)((LAS unsigned char*)lds + LDS_XB); if (threadIdx.x == 0) { st[0] = 0u; st[1] = 0u; st[2] = 0u; st[3] = 0u; } }
    __syncthreads();
    XcdBarrier xbar = xcd_barrier_post((unsigned*)(p.ws + WS_BAR), (volatile LAS unsigned*)((LAS unsigned char*)lds + LDS_XB));
    bf16_t* proj = (bf16_t*)(p.ws + WS_PROJ); bf16_t* r2 = (bf16_t*)(p.ws + WS_R2);
    const float* mod = (const float*)(p.ws + WS_MOD);
    LAS unsigned char* l3 = (LAS unsigned char*)lds;

    if (IN(0)) phase0(p, lds);
    SEAM(0);
    int vbid = blockIdx.x;
    if (IN(0) && IN(1)) {
        volatile LAS unsigned* st = (volatile LAS unsigned*)((LAS unsigned char*)lds + LDS_XB);
        if (threadIdx.x == 0) { unsigned* bar = (unsigned*)(p.ws + WS_BAR); const unsigned G = gridDim.x; bool ok = (G % 8u) == 0u;
            for (unsigned j = 0; j < 16; ++j) { const unsigned cnt = xb_ld(&bar[XB_XCNT(j)]); ok = ok && (j < 8 ? cnt == G / 8u : cnt == 0u); }
            st[3] = ok ? (st[2] * 8u + xbar.x) : (unsigned)blockIdx.x; }
        __syncthreads();
        vbid = (int)st[3];
    }
#ifdef XTRA_SYNC
    for (int e = 0; e < XTRA_SYNC; ++e) grid.sync();
#endif
    if (IN(1)) { phase1_side(p, lds); rows_norm<0>(p, r2); }
    SEAM(1);
    if (IN(2)) { pg8::Gemm g{r2, DM, (const bf16_t*)(p.ws + WS_WIN), NTOK, LDP, DM}; pg8::StaticOrder S; S.init(NTOK, LDP, gridDim.x, vbid);
        pg8::EpiBf16<0> E{proj, LDP}; pg8::gemm_phase(l3, g, S, E); }
    SEAM(2);
    if (IN(3)) phase_rope(p);
    SEAM(3);
    if (IN(4)) { pg8::Gemm g{proj + C_CKV, LDP, (const bf16_t*)(p.ws + WS_WKVB), NTOK, 2048, 512}; pg8::StaticOrder S; S.init(NTOK, 2048, gridDim.x, vbid);
        pg8::EpiBf16<0> E{r2, 2048}; pg8::gemm_phase(l3, g, S, E); }
    SEAM(4);
    if (IN(5)) phase_attn(p, (char*)lds, vbid);
    SEAM(5);
    if (IN(6)) { pg8::Gemm g{proj, LDP, (const bf16_t*)(p.ws + WS_WO), NTOK, DM, DM}; pg8::StaticOrder S; S.init(NTOK, DM, gridDim.x, vbid);
        pg8::EpiWo E{p.x_prompt, p.x_sample, p.out, mod, p.g_mlp, r2, (float*)(p.ws + WS_SS2)}; pg8::gemm_phase(l3, g, S, E); }
    SEAM(6);
    const bool fuse_final = (gridDim.x == 256) && (hi - lo == NPHASE);
#pragma unroll 1
    for (int c = 0; c < 4; ++c) {
        if (IN(8 + 2 * c)) { pg8::Gemm g{r2 + (size_t)c * FCH * DM, DM, (const bf16_t*)(p.ws + WS_WFF1), FCH, DFF, DM}; pg8::StaticOrder S; S.init(FCH, DFF, gridDim.x, vbid);
            pg8::EpiFfn1 E{proj, (const float*)(p.ws + WS_SS2), (const float*)(p.ws + WS_B2), c * FCH}; pg8::gemm_phase(l3, g, S, E); }
        SEAM(8 + 2 * c);
        if (IN(9 + 2 * c)) { pg8::Gemm g{proj, DFF, (const bf16_t*)(p.ws + WS_WFF2), FCH, DM, DFF};   pg8::StaticOrder S; S.init(FCH, DM, gridDim.x, vbid);
            if (fuse_final) { pg8::EpiFinal E{p.out, mod + 5 * DM, p.g_final, (float*)(p.ws + WS_SS), c * FCH, xbar}; pg8::gemm_phase(l3, g, S, E); }
            else { pg8::EpiResGate E{p.out, p.out + (size_t)NPROMPT * DM, p.out, mod + 5 * DM, c * FCH}; pg8::gemm_phase(l3, g, S, E); } }
        if (!fuse_final) SEAM(9 + 2 * c);
    }
    if (IN(16) && !fuse_final) rows_norm<2>(p, nullptr);
#undef IN
#undef SEAM
}

#ifndef N_LAUNCHES
#define N_LAUNCHES 1
#endif
extern "C" void kernel_launch(void* const* d_in, const int* in_sizes, int n_in, void* d_out, int out_size, void* d_ws, size_t ws_size, hipStream_t stream) {
    static int grid = 0;
    if (grid == 0) {
        if (n_in != 17 || ws_size < WS_END) { fprintf(stderr, "kernel_launch: n_in %d ws %zu (need %zu)\n", n_in, ws_size, (size_t)WS_END); grid = -1; return; }
        int dev = 0, cus = 0, per_cu = 0;
        hipGetDevice(&dev); hipDeviceGetAttribute(&cus, hipDeviceAttributeMultiprocessorCount, dev);
        if (hipFuncSetAttribute((const void*)fwd_mega, hipFuncAttributeMaxDynamicSharedMemorySize, LDS_BYTES) != hipSuccess) { fprintf(stderr, "kernel_launch: hipFuncSetAttribute failed\n"); grid = -1; return; }
        if (hipOccupancyMaxActiveBlocksPerMultiprocessor(&per_cu, (const void*)fwd_mega, 512, LDS_BYTES) != hipSuccess || per_cu < 1) { fprintf(stderr, "kernel_launch: occupancy query says %d\n", per_cu); per_cu = 1; }
        (void)hipGetLastError();
        grid = cus * 1;
        fprintf(stderr, "kernel_launch: cus %d per_cu %d grid %d ws %zu\n", cus, per_cu, grid, ws_size);
    }
    if (grid < 0) return;
    Params p{};
    p.x_prompt = (const float*)d_in[0]; p.x_sample = (const float*)d_in[1]; p.c_prompt = (const float*)d_in[2]; p.c_sample = (const float*)d_in[3];
    p.w_ada = (const float*)d_in[4]; p.b_ada = (const float*)d_in[5]; p.g_mix = (const float*)d_in[6]; p.w_in = (const float*)d_in[7]; p.sink = (const float*)d_in[8];
    p.g_kv = (const float*)d_in[9]; p.w_kv_b = (const float*)d_in[10]; p.w_o = (const float*)d_in[11]; p.g_mlp = (const float*)d_in[12]; p.w_ff1 = (const float*)d_in[13];
    p.w_ff2 = (const float*)d_in[14]; p.rel_bias = (const float*)d_in[15]; p.g_final = (const float*)d_in[16];
    p.out = (float*)d_out; p.ws = (unsigned char*)d_ws;
#if N_LAUNCHES == 1
    (void)hipMemsetAsync((char*)d_ws + WS_BAR, 0, 16384, stream);
    p.ph_lo = 0; p.ph_hi = NPHASE; p.coop = 1;
    void* args[] = {&p};
    hipError_t e = hipLaunchCooperativeKernel((void*)fwd_mega, dim3(grid), dim3(512), args, LDS_BYTES, stream);
    if (e != hipSuccess) fprintf(stderr, "cooperative launch failed: %s (grid %d)\n", hipGetErrorString(e), grid);
#else
    for (int k = 0; k < NPHASE; ++k) { p.ph_lo = k; p.ph_hi = k + 1; p.coop = 0;
        hipLaunchKernelGGL(fwd_mega, dim3(grid), dim3(512), LDS_BYTES, stream, p); }
#endif
}
```
